# Optimizing an MI355X kernel written in HIP

```python
import jax, jax.numpy as jnp
from jax import lax
import numpy as np

D_MODEL = 1024
BATCH = 2
SEQ = 8192
DEPTH = 1

LRU_WIDTH = D_MODEL
LRU_HEADS = 16
LRU_BLOCK = LRU_WIDTH // LRU_HEADS
CONV_WIDTH = 4
CONV_LEFT = 2
RGLRU_C = 8.0
N_DIR = 2
N_HEADS = 16
N_KV_HEADS = 4
HEAD_DIM = 64
GROUP = N_HEADS // N_KV_HEADS
WINDOW = 128
BLOCK = 128
D_FF = ((8 * D_MODEL // 3 + 255) // 256) * 256
N_BRANCH = 2
Q_W = N_HEADS * HEAD_DIM
KV_W = N_KV_HEADS * HEAD_DIM
IN_W = 2 * LRU_WIDTH + Q_W + 2 * KV_W + N_BRANCH * D_MODEL
EPS = 1e-6
NEG_INF = -1e30

kernel_name = "hybrid_rglru_swa_gated_encoder"


def rmsnorm(x, g):
    xf = x.astype(jnp.float32)
    y = xf * lax.rsqrt(jnp.mean(xf * xf, axis=-1, keepdims=True) + EPS)
    return (y * g.astype(jnp.float32)).astype(x.dtype)


def centred_depthwise_conv(u, w, b):
    s = u.shape[1]
    up = jnp.pad(u, ((0, 0), (CONV_LEFT, CONV_WIDTH - 1 - CONV_LEFT), (0, 0)))
    out = up[:, 0:s] * w[0]
    for k in range(1, CONV_WIDTH):
        out = out + up[:, k:k + s] * w[k]
    return out + b


def _linear_combine(left, right):
    a1, b1 = left
    a2, b2 = right
    return a1 * a2, a2 * b1 + b2


def rg_lru(u, lam, wa, ba, wx, bx, reverse):
    bsz, s, c = u.shape
    ub = u.reshape(bsz, s, LRU_HEADS, LRU_BLOCK)
    r = jax.nn.sigmoid(jnp.einsum("bshi,hij->bshj", ub, wa.astype(jnp.float32)).reshape(bsz, s, c) + ba.astype(jnp.float32))
    i = jax.nn.sigmoid(jnp.einsum("bshi,hij->bshj", ub, wx.astype(jnp.float32)).reshape(bsz, s, c) + bx.astype(jnp.float32))
    log_a = -RGLRU_C * r * jax.nn.softplus(-lam.astype(jnp.float32))
    a = jnp.exp(log_a)
    beta = jnp.sqrt(jnp.maximum(-jnp.expm1(2.0 * log_a), 0.0))
    _, h = lax.associative_scan(_linear_combine, (a, beta * (i * u)), axis=1, reverse=reverse)
    return h


def banded_alibi_sink_attention(q, k, v, sink):
    bsz, s = q.shape[0], q.shape[1]
    nb = s // BLOCK
    qb = (q.astype(jnp.float32) * (HEAD_DIM ** -0.5)).reshape(bsz, nb, BLOCK, N_KV_HEADS, GROUP, HEAD_DIM)

    def key_blocks(t):
        tp = jnp.pad(t.astype(jnp.float32), ((0, 0), (BLOCK, BLOCK), (0, 0), (0, 0)))
        tp = tp.reshape(bsz, nb + 2, BLOCK, N_KV_HEADS, HEAD_DIM)
        return jnp.concatenate([tp[:, j:j + nb] for j in range(3)], axis=2)

    kb = key_blocks(k)
    vb = key_blocks(v)
    scores = jnp.einsum("bnqkgd,bnskd->bnkgqs", qb, kb)

    q_loc = jnp.arange(BLOCK)
    k_loc = jnp.arange(3 * BLOCK)
    dist = q_loc[:, None] + BLOCK - k_loc[None, :]
    kpos = jnp.arange(nb)[:, None] * BLOCK - BLOCK + k_loc[None, :]
    valid = (jnp.abs(dist) <= WINDOW)[None] & ((kpos >= 0) & (kpos < s))[:, None, :]

    slopes = jnp.exp2(-8.0 * (jnp.arange(N_HEADS, dtype=jnp.float32) + 1.0) / N_HEADS)
    alibi = -slopes.reshape(N_KV_HEADS, GROUP, 1, 1) * jnp.abs(dist).astype(jnp.float32)
    scores = jnp.where(valid[None, :, None, None], scores + alibi, NEG_INF)

    sink_l = sink.astype(jnp.float32).reshape(1, 1, N_KV_HEADS, GROUP, 1, 1)
    m = jnp.maximum(jnp.max(scores, axis=-1, keepdims=True), sink_l)
    p = jnp.exp(scores - m)
    denom = jnp.sum(p, axis=-1, keepdims=True) + jnp.exp(sink_l - m)
    o = jnp.einsum("bnkgqs,bnskd->bnqkgd", p / denom, vb)
    return o.reshape(bsz, s, Q_W)


def setup_inputs(seed: int = 0) -> dict:
    key = jax.random.key(seed)
    ks = jax.random.split(key, 20)
    f32 = jnp.float32
    x = jax.random.normal(ks[0], (BATCH, SEQ, D_MODEL), f32)
    norm_mix_g = 1.0 + 0.05 * jax.random.normal(ks[1], (DEPTH, D_MODEL), f32)
    w_in = jax.random.normal(ks[2], (DEPTH, D_MODEL, IN_W), f32) * D_MODEL ** -0.5
    b_gate = 0.01 * jax.random.normal(ks[3], (DEPTH, N_BRANCH * D_MODEL), f32)
    conv_w = jax.random.normal(ks[4], (DEPTH, CONV_WIDTH, LRU_WIDTH), f32) * CONV_WIDTH ** -0.5
    conv_b = 0.01 * jax.random.normal(ks[5], (DEPTH, LRU_WIDTH), f32)
    u = jax.random.uniform(ks[6], (DEPTH, N_DIR, LRU_WIDTH), f32, minval=0.9, maxval=0.999)
    p = u ** (1.0 / RGLRU_C)
    lru_lambda = jnp.log(p) - jnp.log1p(-p)
    lru_wa = jax.random.normal(ks[7], (DEPTH, N_DIR, LRU_HEADS, LRU_BLOCK, LRU_BLOCK), f32) * LRU_BLOCK ** -0.5
    lru_ba = 0.01 * jax.random.normal(ks[8], (DEPTH, N_DIR, LRU_WIDTH), f32)
    lru_wx = jax.random.normal(ks[9], (DEPTH, N_DIR, LRU_HEADS, LRU_BLOCK, LRU_BLOCK), f32) * LRU_BLOCK ** -0.5
    lru_bx = 0.01 * jax.random.normal(ks[10], (DEPTH, N_DIR, LRU_WIDTH), f32)
    attn_sink = 0.5 * jax.random.normal(ks[11], (DEPTH, N_HEADS), f32)
    w_out = jax.random.normal(ks[12], (DEPTH, D_MODEL, D_MODEL), f32) * D_MODEL ** -0.5
    norm_ffn_g = 1.0 + 0.05 * jax.random.normal(ks[13], (DEPTH, D_MODEL), f32)
    w_ffn_in = jax.random.normal(ks[14], (DEPTH, D_MODEL, 2 * D_FF), f32) * D_MODEL ** -0.5
    w_ffn_out = jax.random.normal(ks[15], (DEPTH, D_FF, D_MODEL), f32) * D_FF ** -0.5
    norm_final_g = 1.0 + 0.05 * jax.random.normal(ks[16], (D_MODEL,), f32)
    return {"x": x, "norm_mix_g": norm_mix_g, "w_in": w_in, "b_gate": b_gate,
            "conv_w": conv_w, "conv_b": conv_b, "lru_lambda": lru_lambda,
            "lru_wa": lru_wa, "lru_ba": lru_ba, "lru_wx": lru_wx, "lru_bx": lru_bx,
            "attn_sink": attn_sink, "w_out": w_out, "norm_ffn_g": norm_ffn_g,
            "w_ffn_in": w_ffn_in, "w_ffn_out": w_ffn_out, "norm_final_g": norm_final_g}


def reference(x, norm_mix_g, w_in, b_gate, conv_w, conv_b, lru_lambda, lru_wa, lru_ba,
              lru_wx, lru_bx, attn_sink, w_out, norm_ffn_g, w_ffn_in, w_ffn_out, norm_final_g):
    bsz, s, _ = x.shape
    splits = [LRU_WIDTH, 2 * LRU_WIDTH, 2 * LRU_WIDTH + Q_W, 2 * LRU_WIDTH + Q_W + KV_W,
              2 * LRU_WIDTH + Q_W + 2 * KV_W]
    for l in range(DEPTH):
        xn = rmsnorm(x, norm_mix_g[l])
        proj = xn @ w_in[l]
        u, g_lru, q, k, v, z = jnp.split(proj, splits, axis=-1)

        uc = centred_depthwise_conv(u, conv_w[l], conv_b[l]).astype(jnp.float32)
        h_fwd = rg_lru(uc, lru_lambda[l, 0], lru_wa[l, 0], lru_ba[l, 0], lru_wx[l, 0], lru_bx[l, 0], False)
        h_bwd = rg_lru(uc, lru_lambda[l, 1], lru_wa[l, 1], lru_ba[l, 1], lru_wx[l, 1], lru_bx[l, 1], True)
        y_a = ((h_fwd + h_bwd) * jax.nn.gelu(g_lru.astype(jnp.float32))).astype(x.dtype)

        y_b = banded_alibi_sink_attention(
            q.reshape(bsz, s, N_HEADS, HEAD_DIM),
            k.reshape(bsz, s, N_KV_HEADS, HEAD_DIM),
            v.reshape(bsz, s, N_KV_HEADS, HEAD_DIM),
            attn_sink[l]).astype(x.dtype)

        gates = jax.nn.sigmoid(z + b_gate[l]).reshape(bsz, s, N_BRANCH, D_MODEL)
        merged = gates[:, :, 0] * y_a + gates[:, :, 1] * y_b
        x = x + merged @ w_out[l]

        xn2 = rmsnorm(x, norm_ffn_g[l])
        gu = xn2 @ w_ffn_in[l]
        ff_gate, ff_up = jnp.split(gu, [D_FF], axis=-1)
        x = x + (jax.nn.silu(ff_gate) * ff_up) @ w_ffn_out[l]
    return rmsnorm(x, norm_final_g)
```

```cpp
#include <hip/hip_runtime.h>
#include <hip/hip_cooperative_groups.h>
#include <cstdio>
#include <cstdint>
namespace cg = cooperative_groups;
namespace pg8 {
#define PG8_LAS __attribute__((address_space(3)))
typedef unsigned short bf16_t;
typedef short bf16x8 __attribute__((ext_vector_type(8)));
typedef float f32x4 __attribute__((ext_vector_type(4)));
typedef unsigned u32x4 __attribute__((ext_vector_type(4)));
constexpr int BM = 256, BK = 64, HALF = 128, HTB = HALF * BK * 2  , STAGE_BYTES = 8 * HTB, NXCD = 8, WGM = 8;

__host__ __device__ __forceinline__ int lds_byte(int r, int c) { const int st = (r >> 4) * 2 + (c >> 5), rr = r & 15, cc = c & 31, ob = rr * 64 + cc * 2; return st * 1024 + (ob ^ (((ob >> 9) & 1) << 5)); }
__host__ __device__ __forceinline__ void stage_rc(int b, int& R, int& C) { const int st = b / 1024, sb = b % 1024, swz = sb ^ (((sb >> 9) & 1) << 5); R = (st >> 1) * 16 + swz / 64; C = (st & 1) * 32 + (swz % 64) / 2; }
__host__ __device__ __forceinline__ int perm32(int rho) { const int n = rho >> 4, i = rho & 15; return 8 * (i >> 2) + 4 * n + (i & 3); }

struct Unit { int pm, pn; };
struct Gemm { const bf16_t* A; const bf16_t* Bt; int M, N, K; };

struct StaticOrder {
    int nM, nN, nwg, G, c;
    __host__ __device__ void init(int M, int N, int G_, int c_) { nM = M / BM; nN = N / BM; nwg = nM * nN; G = G_; c = c_; }
    __host__ __device__ bool next(int i, Unit& u) const {
        const long L = (long)i * G + c; if (L >= nwg) return false;
        int wgid = (int)L; { const int q = nwg / NXCD, r = nwg % NXCD, xcd = wgid % NXCD, off = wgid / NXCD; wgid = (xcd < r ? xcd * (q + 1) : r * (q + 1) + (xcd - r) * q) + off; }
        const int nig = WGM * nN, gid = wgid / nig, fm = gid * WGM, gsz = (nM - fm) < WGM ? (nM - fm) : WGM;
        u.pm = fm + ((wgid % nig) % gsz); u.pn = (wgid % nig) / gsz; return true;
    }
    __device__ __forceinline__ void a_ready(const Unit&) const {}
    __device__ __forceinline__ void done(const Unit&) const {}
};

__device__ __forceinline__ unsigned cvt_pk_bf16(float lo, float hi) { unsigned r; asm volatile("v_cvt_pk_bf16_f32 %0, %1, %2" : "=v"(r) : "v"(lo), "v"(hi)); return r; }
typedef unsigned u32x2 __attribute__((ext_vector_type(2)));
constexpr float RMS_EPS = 1e-6f;
struct EpiProj {
    static constexpr bool PERM = true, AFTER_DRAIN = false;
    bf16_t* proj; bf16_t* vt; const float* ss; float qscale;
    __device__ __forceinline__ void operator()(const f32x4 (&acc)[2][2][4][2], const Unit& u, int wr, int wc, int fr, int fq) const {
        const int row0 = u.pm * BM + wr * 64 + fr, ct = wc * 32 + 8 * fq;
        const float sc = (u.pn >= 8 && u.pn < 12) ? qscale : 1.f;
        if (u.pn != 13) {
            bf16_t* base = proj + (size_t)u.pn * BM + ct;
#pragma unroll
            for (int ai = 0; ai < 2; ++ai)
#pragma unroll
                for (int m = 0; m < 4; ++m) { const int row = row0 + ai * HALF + m * 16; const float rs = rsqrtf(ss[row] * (1.0f / 1024.0f) + RMS_EPS) * sc;
#pragma unroll
                    for (int bj = 0; bj < 2; ++bj) { const f32x4 v0 = acc[ai][bj][m][0] * rs, v1 = acc[ai][bj][m][1] * rs;
                        u32x4 w; w.x = cvt_pk_bf16(v0[0], v0[1]); w.y = cvt_pk_bf16(v0[2], v0[3]); w.z = cvt_pk_bf16(v1[0], v1[1]); w.w = cvt_pk_bf16(v1[2], v1[3]);
                        *(u32x4*)(base + (size_t)row * 5632 + bj * HALF) = w; } }
        } else {
#pragma unroll
            for (int ai = 0; ai < 2; ++ai)
#pragma unroll
                for (int m = 0; m < 4; ++m) { const int row = row0 + ai * HALF + m * 16; const float rs = rsqrtf(ss[row] * (1.0f / 1024.0f) + RMS_EPS);
                    const int b = row >> 13, s = row & 8191;
#pragma unroll
                    for (int bj = 0; bj < 2; ++bj)
#pragma unroll
                        for (int n = 0; n < 2; ++n) { const f32x4 v = acc[ai][bj][m][n] * rs;
#pragma unroll
                            for (int e = 0; e < 4; ++e) { const int cidx = bj * HALF + ct + 4 * n + e, g = cidx >> 6, d = cidx & 63;
                                vt[(size_t)((b * 4 + g) * 64 + d) * 8192 + s] = (bf16_t)(cvt_pk_bf16(v[e], 0.f) & 0xffffu); } } }
        }
    }
};
struct EpiResid {
    static constexpr bool PERM = false, AFTER_DRAIN = false;
    const float* base; float* out; bf16_t* ob; float* ss;
    __device__ __forceinline__ void operator()(const f32x4 (&acc)[2][2][4][2], const Unit& u, int wr, int wc, int fr, int fq) const {
        const int col0 = u.pn * BM + wc * 32 + 4 * fq;
#pragma unroll
        for (int ai = 0; ai < 2; ++ai)
#pragma unroll
            for (int m = 0; m < 4; ++m) { const int row = u.pm * BM + ai * HALF + wr * 64 + m * 16 + fr; const size_t off = (size_t)row * 1024 + col0; float q = 0.f;
#pragma unroll
                for (int bj = 0; bj < 2; ++bj)
#pragma unroll
                    for (int n = 0; n < 2; ++n) { const size_t o_ = off + bj * HALF + n * 16; const f32x4 bs = *(const f32x4*)(base + o_); const f32x4 o = bs + acc[ai][bj][m][n];
                        *(f32x4*)(out + o_) = o; q += (o[0] * o[0] + o[1] * o[1]) + (o[2] * o[2] + o[3] * o[3]);
                        if (ob) { u32x2 w; w.x = cvt_pk_bf16(o[0], o[1]); w.y = cvt_pk_bf16(o[2], o[3]); *(u32x2*)(ob + o_) = w; } }
                q += __shfl_xor(q, 16); q += __shfl_xor(q, 32);
                if (fq == 0) atomicAdd(ss + row, q);
                if (m & 1) asm volatile("" ::: "memory"); }
    }
};
struct EpiSwiGLU {
    static constexpr bool PERM = true, AFTER_DRAIN = false;
    bf16_t* H; const float* ss;
    __device__ __forceinline__ void operator()(const f32x4 (&acc)[2][2][4][2], const Unit& u, int wr, int wc, int fr, int fq) const {
        const int row0 = u.pm * BM + wr * 64 + fr, col = u.pn * HALF + wc * 32 + 8 * fq;
#pragma unroll
        for (int ai = 0; ai < 2; ++ai)
#pragma unroll
            for (int m = 0; m < 4; ++m) { const int row = row0 + ai * HALF + m * 16; const float rs = rsqrtf(ss[row] * (1.0f / 1024.0f) + RMS_EPS);
                float hv[8];
#pragma unroll
                for (int n = 0; n < 2; ++n) { const f32x4 g = acc[ai][0][m][n] * rs, up = acc[ai][1][m][n] * rs;
#pragma unroll
                    for (int e = 0; e < 4; ++e) { const float sg = __builtin_amdgcn_rcpf(1.f + __builtin_amdgcn_exp2f(-1.4426950408889634f * g[e])); hv[4 * n + e] = g[e] * sg * up[e]; } }
                u32x4 w; w.x = cvt_pk_bf16(hv[0], hv[1]); w.y = cvt_pk_bf16(hv[2], hv[3]); w.z = cvt_pk_bf16(hv[4], hv[5]); w.w = cvt_pk_bf16(hv[6], hv[7]);
                *(u32x4*)(H + (size_t)row * 2816 + col) = w; }
    }
};
template <class Epi, class Sched, bool ALIGN_EPI = false, bool SP2 = false>
__device__ __forceinline__ void gemm_phase(PG8_LAS unsigned char* lds, const Gemm g, const Sched& S, const Epi& E) {
    const int tid = threadIdx.x, wid = __builtin_amdgcn_readfirstlane(tid >> 6), lane = tid & 63, wr = wid >> 2, wc = wid & 3, fr = lane & 15, fq = lane >> 4;
    const int K = g.K, nt = K / BK;
    unsigned voffA[2], voffB[2];
#pragma unroll
    for (int i = 0; i < 2; ++i) { int R, C; stage_rc(tid * 16 + i * 8192, R, C); const int Rb = Epi::PERM ? ((R & ~31) + perm32(R & 31)) : R;
        voffA[i] = (unsigned)(R * K + C) * 2u; voffB[i] = (unsigned)(Rb * K + C) * 2u; }
    const size_t kstep = (size_t)(BK * 2);
    const size_t hstep = (size_t)HALF * K * 2;
    const size_t tstep = 2 * hstep;
    const unsigned ldsw = (unsigned)wid * 1024u;
    const int aoff = lds_byte(wr * 64 + fr, fq * 8), boff = lds_byte(wc * 32 + fr, fq * 8);
#define PG8_SA(b, h) (((b) * 2 + (h)) * HTB)
#define PG8_SB(b, h) ((4 + (b) * 2 + (h)) * HTB)
#define PG8_STAGE(bufoff, gbase, voff) do { _Pragma("unroll") for (int _i = 0; _i < 2; ++_i) \
        __builtin_amdgcn_global_load_lds((const unsigned*)((const char*)(gbase) + (voff)[_i]), (PG8_LAS unsigned*)(lds + (bufoff) + ldsw + _i * 8192), 16, 0, 0); } while (0)
#define PG8_LDA(dst, b, h) do { _Pragma("unroll") for (int m = 0; m < 4; ++m) _Pragma("unroll") for (int k = 0; k < 2; ++k) dst[m][k] = *(const PG8_LAS bf16x8*)(lds + PG8_SA(b, h) + aoff + m * 2048 + k * 1024); } while (0)
#define PG8_LDB(dst, b, h) do { _Pragma("unroll") for (int n = 0; n < 2; ++n) _Pragma("unroll") for (int k = 0; k < 2; ++k) dst[n][k] = *(const PG8_LAS bf16x8*)(lds + PG8_SB(b, h) + boff + n * 2048 + k * 1024); } while (0)
#define PG8_MMA(ai, bj, At, Bt) do { __builtin_amdgcn_s_setprio(1); _Pragma("unroll") for (int m = 0; m < 4; ++m) _Pragma("unroll") for (int n = 0; n < 2; ++n) _Pragma("unroll") for (int k = 0; k < 2; ++k) \
        acc[ai][bj][m][n] = __builtin_amdgcn_mfma_f32_16x16x32_bf16(Bt[n][k], At[m][k], acc[ai][bj][m][n], 0, 0, 0); __builtin_amdgcn_s_setprio(0); } while (0)
#define PG8_WAIT_V(n) asm volatile("s_waitcnt vmcnt(" #n ")" ::: "memory")
#define PG8_WAIT_L(n) asm volatile("s_waitcnt lgkmcnt(" #n ")" ::: "memory")
#define PG8_BAR __builtin_amdgcn_s_barrier()
#define PG8_SCHED __builtin_amdgcn_sched_barrier(0)
    Unit cur, nxt; int ui = 0;
    if (!S.next(0, cur)) return;
    f32x4 acc[2][2][4][2];
#pragma unroll
    for (int a = 0; a < 2; ++a)
#pragma unroll
        for (int b = 0; b < 2; ++b)
#pragma unroll
            for (int m = 0; m < 4; ++m)
#pragma unroll
                for (int n = 0; n < 2; ++n) acc[a][b][m][n] = (f32x4){0.f, 0.f, 0.f, 0.f};
    bf16x8 At[4][2], B0[2][2], B1[2][2];
    const char* cA = (const char*)g.A + (size_t)cur.pm * tstep; const char* cB = (const char*)g.Bt + (size_t)cur.pn * tstep;
    S.a_ready(cur);
    if constexpr (SP2) {
        PG8_STAGE(PG8_SB(0, 0), cB, voffB); PG8_STAGE(PG8_SB(0, 1), cB + hstep, voffB); PG8_STAGE(PG8_SA(0, 0), cA, voffA); PG8_STAGE(PG8_SA(0, 1), cA + hstep, voffA);
        if (wr == 1) PG8_BAR;
        PG8_WAIT_V(2); PG8_BAR;
        PG8_STAGE(PG8_SB(1, 0), cB + kstep, voffB); PG8_STAGE(PG8_SA(1, 0), cA + kstep, voffA); PG8_STAGE(PG8_SB(1, 1), cB + hstep + kstep, voffB);
        PG8_WAIT_V(6); PG8_BAR;
    } else {
        PG8_STAGE(PG8_SB(0, 0), cB, voffB); PG8_STAGE(PG8_SA(0, 0), cA, voffA); PG8_STAGE(PG8_SB(0, 1), cB + hstep, voffB); PG8_STAGE(PG8_SA(0, 1), cA + hstep, voffA);
        if (wr == 1) PG8_BAR;
        PG8_WAIT_V(4); PG8_BAR;
        PG8_STAGE(PG8_SB(1, 0), cB + kstep, voffB); PG8_STAGE(PG8_SA(1, 0), cA + kstep, voffA); PG8_STAGE(PG8_SB(1, 1), cB + hstep + kstep, voffB);
        PG8_WAIT_V(6); PG8_BAR;
    }
    for (;;) {
        const bool has_next = S.next(ui + 1, nxt);
        const char* nA = has_next ? (const char*)g.A + (size_t)nxt.pm * tstep : cA; const char* nB = has_next ? (const char*)g.Bt + (size_t)nxt.pn * tstep : cB;
        for (int t = 0; t < nt; t += 2) {
            const bool last = (t == nt - 2);
            const char* a1 = cA + (size_t)(t + 1) * kstep;
            const char* a2 = last ? nA : cA + (size_t)(t + 2) * kstep; const char* b2 = last ? nB : cB + (size_t)(t + 2) * kstep;
            const char* a3 = a2 + kstep; const char* b3 = b2 + kstep;
            if (last && has_next) S.a_ready(nxt);
            if constexpr (SP2) {
            PG8_LDB(B0, 0, 0); PG8_LDB(B1, 0, 1); PG8_SCHED; PG8_LDA(At, 0, 0); PG8_STAGE(PG8_SA(1, 1), a1 + hstep, voffA);
            PG8_WAIT_V(8); PG8_WAIT_L(0); PG8_BAR; PG8_MMA(0, 0, At, B0); PG8_MMA(0, 1, At, B1); PG8_BAR; PG8_SCHED;
            PG8_LDA(At, 0, 1); PG8_STAGE(PG8_SB(0, 0), b2, voffB); PG8_STAGE(PG8_SB(0, 1), b2 + hstep, voffB); PG8_STAGE(PG8_SA(0, 0), a2, voffA);
            PG8_WAIT_V(8); PG8_WAIT_L(0); PG8_BAR; PG8_MMA(1, 0, At, B0); PG8_MMA(1, 1, At, B1); PG8_BAR; PG8_SCHED;
            PG8_LDB(B0, 1, 0); PG8_LDB(B1, 1, 1); PG8_SCHED; PG8_LDA(At, 1, 0); PG8_STAGE(PG8_SA(0, 1), a2 + hstep, voffA);
            PG8_WAIT_V(8); PG8_WAIT_L(0); PG8_BAR; PG8_MMA(0, 0, At, B0); PG8_MMA(0, 1, At, B1); PG8_BAR; PG8_SCHED;
            PG8_LDA(At, 1, 1); PG8_STAGE(PG8_SB(1, 0), b3, voffB); PG8_STAGE(PG8_SB(1, 1), b3 + hstep, voffB); PG8_STAGE(PG8_SA(1, 0), a3, voffA);
            PG8_WAIT_V(8); PG8_WAIT_L(0); PG8_BAR; PG8_MMA(1, 0, At, B0); PG8_MMA(1, 1, At, B1); PG8_BAR; PG8_SCHED;
            } else {
            PG8_LDB(B0, 0, 0); PG8_SCHED; PG8_LDA(At, 0, 0); PG8_STAGE(PG8_SA(1, 1), a1 + hstep, voffA);
            PG8_WAIT_L(8); PG8_BAR; PG8_WAIT_L(0); PG8_MMA(0, 0, At, B0); PG8_BAR; PG8_SCHED;
            PG8_LDB(B1, 0, 1); PG8_STAGE(PG8_SB(0, 0), b2, voffB);
            PG8_BAR; PG8_WAIT_L(0); PG8_MMA(0, 1, At, B1); PG8_BAR;
            PG8_LDA(At, 0, 1); PG8_STAGE(PG8_SA(0, 0), a2, voffA);
            PG8_BAR; PG8_WAIT_L(0); PG8_MMA(1, 0, At, B0); PG8_BAR; PG8_SCHED;
            PG8_STAGE(PG8_SB(0, 1), b2 + hstep, voffB);
            PG8_WAIT_V(6); PG8_BAR; PG8_MMA(1, 1, At, B1); PG8_BAR;
            PG8_LDB(B0, 1, 0); PG8_SCHED; PG8_LDA(At, 1, 0); PG8_STAGE(PG8_SA(0, 1), a2 + hstep, voffA);
            PG8_WAIT_L(8); PG8_BAR; PG8_WAIT_L(0); PG8_MMA(0, 0, At, B0); PG8_BAR; PG8_SCHED;
            PG8_LDB(B1, 1, 1); PG8_STAGE(PG8_SB(1, 0), b3, voffB);
            PG8_BAR; PG8_WAIT_L(0); PG8_MMA(0, 1, At, B1); PG8_BAR;
            PG8_LDA(At, 1, 1); PG8_STAGE(PG8_SA(1, 0), a3, voffA);
            PG8_BAR; PG8_WAIT_L(0); PG8_MMA(1, 0, At, B0); PG8_BAR; PG8_SCHED;
            PG8_STAGE(PG8_SB(1, 1), b3 + hstep, voffB);
            PG8_WAIT_V(6); PG8_BAR; PG8_MMA(1, 1, At, B1); PG8_BAR;
            }
        }
        if constexpr (ALIGN_EPI) { if (wr == 0) PG8_BAR; }
        if constexpr (!Epi::AFTER_DRAIN) { E(acc, cur, wr, wc, fr, fq); S.done(cur); }
        if (!has_next) break;
#pragma unroll
        for (int a = 0; a < 2; ++a)
#pragma unroll
            for (int b = 0; b < 2; ++b)
#pragma unroll
                for (int m = 0; m < 4; ++m)
#pragma unroll
                    for (int n = 0; n < 2; ++n) acc[a][b][m][n] = (f32x4){0.f, 0.f, 0.f, 0.f};
        cur = nxt; cA = nA; cB = nB; ++ui;
        if constexpr (ALIGN_EPI) { if (wr == 1) PG8_BAR; }
    }
    PG8_WAIT_V(0);
    if constexpr (!ALIGN_EPI) { if (wr == 0) PG8_BAR; }
    PG8_BAR;
    if constexpr (Epi::AFTER_DRAIN) { E.fused(acc, cur, wr, wc, fr, fq, lds, wid, lane); S.done(cur); }
#undef PG8_SA
#undef PG8_SB
#undef PG8_STAGE
#undef PG8_LDA
#undef PG8_LDB
#undef PG8_MMA
#undef PG8_WAIT_V
#undef PG8_WAIT_L
#undef PG8_BAR
#undef PG8_SCHED
}
}
#ifndef MK_LAUNCHES
#define MK_LAUNCHES 1
#endif
#define LAS __attribute__((address_space(3)))
typedef unsigned short bf16;
typedef unsigned u32x4 __attribute__((ext_vector_type(4)));
typedef unsigned u32x2 __attribute__((ext_vector_type(2)));
typedef float f32x4 __attribute__((ext_vector_type(4)));
typedef float f32x2 __attribute__((ext_vector_type(2)));
typedef float f32x16 __attribute__((ext_vector_type(16)));
typedef short bf16x8 __attribute__((ext_vector_type(8)));
typedef __bf16 bf16x2_t __attribute__((ext_vector_type(2)));

constexpr int NWAVES = 8, NTHR = 512, NPH = 8;
constexpr int B_ = 2, S_ = 8192, D_ = 1024, M_ = B_ * S_, INW = 5632, DFF = 2816;
constexpr float LOG2E = 1.4426950408889634f;
constexpr float QSCALE = 0.125f * LOG2E;
constexpr size_t MiB = 1u << 20;
constexpr size_t WS_WIN = 0, WS_WFFI = 11 * MiB, WS_WOUT = 22 * MiB, WS_WFFO = 24 * MiB, WS_WG = 30 * MiB, WS_SS = 31 * MiB, WS_CAGG = 32 * MiB, WS_VT = 34 * MiB,
                 WS_XB = 42 * MiB  , WS_PROJ = 74 * MiB  , WS_X1B = WS_PROJ  , WS_H = 106 * MiB  , WS_END = 250 * MiB;
constexpr int LDS_BYTES = 131072 + 1024;

__device__ __forceinline__ float bflo(unsigned w) { return __uint_as_float(w << 16); }
__device__ __forceinline__ float bfhi(unsigned w) { return __uint_as_float(w & 0xffff0000u); }
__device__ __forceinline__ unsigned pkbf(float lo, float hi) { f32x2 v = {lo, hi}; bf16x2_t b = __builtin_convertvector(v, bf16x2_t); return __builtin_bit_cast(unsigned, b); }
__device__ __forceinline__ float ex2(float x) { return __builtin_amdgcn_exp2f(x); }
__device__ __forceinline__ float rcp_(float x) { return __builtin_amdgcn_rcpf(x); }
__device__ __forceinline__ float sigm(float x) { return rcp_(1.f + ex2(-LOG2E * x)); }
__device__ __forceinline__ float wave_sum(float v) {
#pragma unroll
    for (int o = 1; o < 64; o <<= 1) v += __shfl_xor(v, o);
    return v;
}

template <int MODE>
__device__ __forceinline__ void transpose_item(const float* W, int K, int N, const float* gk, bf16* WT, LAS float* scr, int item, int lane) {
    const int nblk = N / 32, kb = item / nblk, nb = item % nblk, k0 = 64 * kb, n0 = 32 * nb;
#pragma unroll 8
    for (int i = 0; i < 32; ++i) { const int kk = 2 * i + (lane >> 5); float w = W[(size_t)(k0 + kk) * N + n0 + (lane & 31)]; if (gk) w *= gk[k0 + kk]; scr[kk * 33 + (lane & 31)] = w; }
    asm volatile("s_waitcnt lgkmcnt(0)" ::: "memory");
    const int c = lane & 7;
#pragma unroll
    for (int j = 0; j < 4; ++j) { const int n = (lane >> 3) + 8 * j; const LAS float* s = scr + (8 * c) * 33 + n;
        u32x4 o; o.x = pkbf(s[0 * 33], s[1 * 33]); o.y = pkbf(s[2 * 33], s[3 * 33]); o.z = pkbf(s[4 * 33], s[5 * 33]); o.w = pkbf(s[6 * 33], s[7 * 33]);
        const int nn = n0 + n; int drow = nn;
        if (MODE == 1) drow = (nn < DFF) ? ((nn >> 7) * 256 + (nn & 127)) : (((nn - DFF) >> 7) * 256 + 128 + ((nn - DFF) & 127));
        *(u32x4*)(WT + (size_t)drow * K + k0 + 8 * c) = o; }
    asm volatile("s_waitcnt lgkmcnt(0)" ::: "memory");
}

constexpr int KS_OFF = 0, KS_PITCH = 144, VTS_OFF = 320 * KS_PITCH, VTS_PITCH = 656;
__device__ __forceinline__ int crow(int r, int hi) { return (r & 3) + 8 * (r >> 2) + 4 * hi; }
__device__ __forceinline__ void attn_unit(LAS unsigned char* lds, bf16* proj, const bf16* vt, const float* sink, int b, int g, int qb, int tid) {
    const int lane = tid & 63, wave = __builtin_amdgcn_readfirstlane(tid >> 6), r32 = lane & 31, hi = lane >> 5;
    const int q0 = 64 * qb, kb = q0 - 128; const size_t rowbase = (size_t)b * S_;
    for (int id = tid; id < 2560; id += NTHR) { const int kr = id >> 3, c = id & 7, s = kb + kr; u32x4 v = {0u, 0u, 0u, 0u};
        if (s >= 0 && s < S_) v = *(const u32x4*)(proj + (rowbase + s) * INW + 3072 + 64 * g + 8 * c);
        *(LAS u32x4*)(lds + KS_OFF + kr * KS_PITCH + c * 16) = v; }
    for (int id = tid; id < 2560; id += NTHR) { const int d = id / 40, c = id - 40 * d, s = kb + 8 * c; u32x4 v = {0u, 0u, 0u, 0u};
        if (s >= 0 && s < S_) v = *(const u32x4*)(vt + (size_t)((b * 4 + g) * 64 + d) * S_ + s);
        *(LAS u32x4*)(lds + VTS_OFF + d * VTS_PITCH + c * 16) = v; }
    const int hh = 4 * g + (wave >> 1), qh = wave & 1, t = q0 + 32 * qh + r32;
    bf16* qp = proj + (rowbase + t) * INW + 2048 + 64 * hh;
    bf16x8 qf[4];
#pragma unroll
    for (int ds = 0; ds < 4; ++ds) qf[ds] = *(const bf16x8*)(qp + 16 * ds + 8 * hi);
    const float slope2 = exp2f(-0.5f * (float)(hh + 1)) * LOG2E, sink2 = sink[hh] * LOG2E;
    __syncthreads();
    float m = sink2, l = (hi == 0) ? 1.f : 0.f;
    f32x16 o0, o1;
#pragma unroll
    for (int i = 0; i < 16; ++i) { o0[i] = 0.f; o1[i] = 0.f; }
    for (int j = 0; j < 9; ++j) {
        const int kt = 32 * qh + 32 * j;
        f32x16 p;
#pragma unroll
        for (int i = 0; i < 16; ++i) p[i] = 0.f;
#pragma unroll
        for (int ds = 0; ds < 4; ++ds) { const bf16x8 kf = *(const LAS bf16x8*)(lds + KS_OFF + (kt + r32) * KS_PITCH + 32 * ds + 16 * hi);
            p = __builtin_amdgcn_mfma_f32_32x32x16_bf16(kf, qf[ds], p, 0, 0, 0); }
        float mx = -1e30f;
#pragma unroll
        for (int i = 0; i < 16; ++i) { const int kk = crow(i, hi), dist = r32 + 128 - 32 * j - kk, sa = kb + kt + kk;
            const bool valid = (dist <= 128) && (dist >= -128) && (sa >= 0) && (sa < S_);
            const float sc = valid ? (p[i] - slope2 * fabsf((float)dist)) : -1e30f; p[i] = sc; mx = fmaxf(mx, sc); }
        mx = fmaxf(mx, __shfl_xor(mx, 32));
        const float mnew = fmaxf(m, mx), alpha = ex2(m - mnew); m = mnew;
        float rs = 0.f;
#pragma unroll
        for (int i = 0; i < 16; ++i) { p[i] = ex2(p[i] - mnew); rs += p[i]; }
        l = l * alpha + rs;
#pragma unroll
        for (int i = 0; i < 16; ++i) { o0[i] *= alpha; o1[i] *= alpha; }
        u32x4 w0, w1;
        w0.x = pkbf(p[0], p[1]); w0.y = pkbf(p[2], p[3]); w0.z = pkbf(p[4], p[5]); w0.w = pkbf(p[6], p[7]);
        w1.x = pkbf(p[8], p[9]); w1.y = pkbf(p[10], p[11]); w1.z = pkbf(p[12], p[13]); w1.w = pkbf(p[14], p[15]);
        const bf16x8 pb0 = __builtin_bit_cast(bf16x8, w0), pb1 = __builtin_bit_cast(bf16x8, w1);
#pragma unroll
        for (int s = 0; s < 2; ++s) {
            const LAS unsigned char* vp = lds + VTS_OFF + r32 * VTS_PITCH + 2 * (kt + 16 * s + 4 * hi);
            u32x2 a0 = *(const LAS u32x2*)(vp), a1 = *(const LAS u32x2*)(vp + 16);
            u32x2 c0 = *(const LAS u32x2*)(vp + 32 * VTS_PITCH), c1 = *(const LAS u32x2*)(vp + 32 * VTS_PITCH + 16);
            u32x4 va = {a0.x, a0.y, a1.x, a1.y}, vc = {c0.x, c0.y, c1.x, c1.y};
            o0 = __builtin_amdgcn_mfma_f32_32x32x16_bf16(__builtin_bit_cast(bf16x8, va), s == 0 ? pb0 : pb1, o0, 0, 0, 0);
            o1 = __builtin_amdgcn_mfma_f32_32x32x16_bf16(__builtin_bit_cast(bf16x8, vc), s == 0 ? pb0 : pb1, o1, 0, 0, 0);
        }
    }
    l += __shfl_xor(l, 32);
    const float inv = 1.f / l;
#pragma unroll
    for (int g4 = 0; g4 < 4; ++g4) {
        u32x2 w; w.x = pkbf(o0[4 * g4] * inv, o0[4 * g4 + 1] * inv); w.y = pkbf(o0[4 * g4 + 2] * inv, o0[4 * g4 + 3] * inv);
        *(u32x2*)(qp + 8 * g4 + 4 * hi) = w;
        u32x2 w2; w2.x = pkbf(o1[4 * g4] * inv, o1[4 * g4 + 1] * inv); w2.y = pkbf(o1[4 * g4 + 2] * inv, o1[4 * g4 + 3] * inv);
        *(u32x2*)(qp + 32 + 8 * g4 + 4 * hi) = w2;
    }
    __syncthreads();
}

constexpr int SU_OFF = 0, SUCB_OFF = 16896, SUCB_PITCH = 144, SUCF_OFF = 35328, SAGG_OFF = 68608, SCAR_OFF = 76800;
template <bool PASS2>
__device__ __forceinline__ void scan_unit(LAS unsigned char* lds, const bf16* proj, const bf16* wg, const float* conv_w, const float* conv_b, const float* lam, const float* lba, const float* lbx,
                                          const float* b_gate, f32x4* cagg, bf16* merged, int b, int j, int h, int jl, int tid) {
    const int lane = tid & 63, wave = __builtin_amdgcn_readfirstlane(tid >> 6), cg_ = wave & 3, th = wave >> 2, c16 = lane & 15, q = lane >> 4;
    const int t0 = j * 128; const size_t rowbase = (size_t)b * S_;
    for (int id = tid; id < 131 * 8; id += NTHR) { const int rr = id >> 3, c = id & 7, t = t0 - 2 + rr; u32x4 v = {0u, 0u, 0u, 0u};
        if (t >= 0 && t < S_) v = *(const u32x4*)(proj + (rowbase + t) * INW + 64 * h + 8 * c);
        *(LAS u32x4*)(lds + SU_OFF + rr * 128 + c * 16) = v; }
    u32x4 pg[2], pza[2], pzb[2], pyb[2];
    if (PASS2) {
#pragma unroll
        for (int k = 0; k < 2; ++k) { const int id = tid + NTHR * k, tl = id >> 3, c8 = id & 7; const bf16* rp = proj + (rowbase + t0 + tl) * INW + 64 * h + 8 * c8;
            pg[k] = *(const u32x4*)(rp + 1024); pyb[k] = *(const u32x4*)(rp + 2048); pza[k] = *(const u32x4*)(rp + 3584); pzb[k] = *(const u32x4*)(rp + 4608); }
    }
    __syncthreads();
    { const int cp = tid & 31, tg = tid >> 5, ch0 = 64 * h + 2 * cp;
      float w0[4], w1[4];
#pragma unroll
      for (int k = 0; k < 4; ++k) { w0[k] = conv_w[k * 1024 + ch0]; w1[k] = conv_w[k * 1024 + ch0 + 1]; }
      const float bb0 = conv_b[ch0], bb1 = conv_b[ch0 + 1];
      float u0[11], u1[11];
#pragma unroll
      for (int r = 0; r < 11; ++r) { const unsigned w_ = *(const LAS unsigned*)(lds + SU_OFF + (8 * tg + r) * 128 + 4 * cp); u0[r] = bflo(w_); u1[r] = bfhi(w_); }
#pragma unroll
      for (int tt = 0; tt < 8; ++tt) { const float o0 = bb0 + w0[0] * u0[tt] + w0[1] * u0[tt + 1] + w0[2] * u0[tt + 2] + w0[3] * u0[tt + 3];
          const float o1 = bb1 + w1[0] * u1[tt] + w1[1] * u1[tt + 1] + w1[2] * u1[tt + 2] + w1[3] * u1[tt + 3]; const int tl = 8 * tg + tt;
          *(LAS unsigned*)(lds + SUCB_OFF + tl * SUCB_PITCH + 4 * cp) = pkbf(o0, o1);
          LAS float* f = (LAS float*)(lds + SUCF_OFF) + tl * 65 + 2 * cp; f[0] = o0; f[1] = o1; } }
    __syncthreads();
    f32x4 acc[4][4];
#pragma unroll
    for (int mt = 0; mt < 4; ++mt)
#pragma unroll
        for (int n = 0; n < 4; ++n) acc[mt][n] = (f32x4){0.f, 0.f, 0.f, 0.f};
    { bf16x8 bfr[4][2];
#pragma unroll
      for (int n = 0; n < 4; ++n)
#pragma unroll
          for (int ks = 0; ks < 2; ++ks) bfr[n][ks] = *(const bf16x8*)(wg + (size_t)(((((h * 4 + cg_) * 4 + n) * 2 + ks) * 64 + lane)) * 8);
#pragma unroll
      for (int mt = 0; mt < 4; ++mt)
#pragma unroll
          for (int ks = 0; ks < 2; ++ks) { const int trow = 64 * th + 16 * (c16 >> 2) + 4 * mt + (c16 & 3);
              const bf16x8 af = *(const LAS bf16x8*)(lds + SUCB_OFF + trow * SUCB_PITCH + (32 * ks + 8 * q) * 2);
#pragma unroll
              for (int n = 0; n < 4; ++n) acc[mt][n] = __builtin_amdgcn_mfma_f32_16x16x32_bf16(af, bfr[n][ks], acc[mt][n], 0, 0, 0); } }
    const int ch = 16 * cg_ + c16, gch = 64 * h + ch;
    float ba_[2], bx_[2], sp8[2];
#pragma unroll
    for (int d = 0; d < 2; ++d) { ba_[d] = lba[d * 1024 + gch]; bx_[d] = lbx[d * 1024 + gch]; const float z = -lam[d * 1024 + gch]; sp8[d] = 8.f * (fmaxf(z, 0.f) + log1pf(expf(-fabsf(z)))); }
    { const LAS float* ucf = (const LAS float*)(lds + SUCF_OFF) + (64 * th + 16 * q) * 65 + ch;
#pragma unroll
      for (int mt = 0; mt < 4; ++mt)
#pragma unroll
          for (int i = 0; i < 4; ++i) { const float uc = ucf[(4 * mt + i) * 65];
#pragma unroll
              for (int d = 0; d < 2; ++d) { const float r = sigm(acc[mt][2 * d][i] + ba_[d]), ig = sigm(acc[mt][2 * d + 1][i] + bx_[d]);
                  const float la = -r * sp8[d], a = ex2(la * LOG2E), x2 = 2.f * la;
                  const float em = (x2 > -0.1f) ? (-x2 * (1.f + x2 * (0.5f + x2 * (0.16666667f + x2 * 0.041666668f)))) : (1.f - a * a);
                  acc[mt][2 * d][i] = a; acc[mt][2 * d + 1][i] = sqrtf(fmaxf(em, 0.f)) * ig * uc; } } }
    float Af = 1.f, Hf = 0.f, Ab = 1.f, Hb = 0.f;
#pragma unroll
    for (int k = 0; k < 16; ++k) { const float a = acc[k >> 2][0][k & 3]; Hf = a * Hf + acc[k >> 2][1][k & 3]; Af *= a; }
#pragma unroll
    for (int k = 15; k >= 0; --k) { const float a = acc[k >> 2][2][k & 3]; Hb = a * Hb + acc[k >> 2][3][k & 3]; Ab *= a; }
    const int s = 4 * th + q;
    LAS f32x4* AG = (LAS f32x4*)(lds + SAGG_OFF);
    AG[s * 64 + ch] = (f32x4){Af, Hf, Ab, Hb};
    __syncthreads();
    if (!PASS2) {
        if (tid < 64) { float A = 1.f, H = 0.f, A2 = 1.f, H2 = 0.f;
#pragma unroll
            for (int sp = 0; sp < 8; ++sp) { const f32x4 v = AG[sp * 64 + tid]; H = v[0] * H + v[1]; A *= v[0]; }
#pragma unroll
            for (int sp = 7; sp >= 0; --sp) { const f32x4 v = AG[sp * 64 + tid]; H2 = v[2] * H2 + v[3]; A2 *= v[2]; }
            cagg[(size_t)(b * 64 + j) * 1024 + 64 * h + tid] = (f32x4){A, H, A2, H2}; }
    } else {
        const LAS float* car = (const LAS float*)(lds + SCAR_OFF) + jl * 128;
        float cf = car[ch], cb = car[64 + ch];
#pragma unroll
        for (int sp = 0; sp < 8; ++sp) { const f32x4 v = AG[sp * 64 + ch]; if (sp < s) cf = v[0] * cf + v[1]; }
#pragma unroll
        for (int sp = 7; sp >= 0; --sp) { const f32x4 v = AG[sp * 64 + ch]; if (sp > s) cb = v[2] * cb + v[3]; }
        float y[16];
        { float H = cf;
#pragma unroll
          for (int k = 0; k < 16; ++k) { H = acc[k >> 2][0][k & 3] * H + acc[k >> 2][1][k & 3]; y[k] = H; }
          H = cb;
#pragma unroll
          for (int k = 15; k >= 0; --k) { H = acc[k >> 2][2][k & 3] * H + acc[k >> 2][3][k & 3]; y[k] += H; } }
        { LAS float* sy = (LAS float*)(lds + SUCF_OFF) + (64 * th + 16 * q) * 65 + ch;
#pragma unroll
          for (int k = 0; k < 16; ++k) sy[k * 65] = y[k]; }
        __syncthreads();
        const int c8 = tid & 7;
        float bgA[8], bgB[8];
#pragma unroll
        for (int e = 0; e < 8; ++e) { bgA[e] = b_gate[64 * h + 8 * c8 + e]; bgB[e] = b_gate[1024 + 64 * h + 8 * c8 + e]; }
#pragma unroll
        for (int k = 0; k < 2; ++k) { const int id = tid + NTHR * k, tl = id >> 3; const LAS float* sy = (const LAS float*)(lds + SUCF_OFF) + tl * 65 + 8 * c8;
            float mv[8];
#pragma unroll
            for (int e2 = 0; e2 < 4; ++e2) {
                const unsigned gw = pg[k][e2], zaw = pza[k][e2], zbw = pzb[k][e2], ybw = pyb[k][e2];
#pragma unroll
                for (int hf = 0; hf < 2; ++hf) { const int e = 2 * e2 + hf;
                    const float gg = hf ? bfhi(gw) : bflo(gw), za = hf ? bfhi(zaw) : bflo(zaw), zb = hf ? bfhi(zbw) : bflo(zbw), yb = hf ? bfhi(ybw) : bflo(ybw);
                    const float zz = 0.7978845608028654f * (gg + 0.044715f * gg * gg * gg);
                    const float ya = sy[e] * gg * sigm(2.f * zz);
                    mv[e] = sigm(za + bgA[e]) * ya + sigm(zb + bgB[e]) * yb; } }
            u32x4 w; w.x = pkbf(mv[0], mv[1]); w.y = pkbf(mv[2], mv[3]); w.z = pkbf(mv[4], mv[5]); w.w = pkbf(mv[6], mv[7]);
            *(u32x4*)(merged + (rowbase + t0 + tl) * 1024 + 64 * h + 8 * c8) = w; }
    }
}

struct Params { const float* in[17]; float* out; unsigned char* ws; int ph_lo, ph_hi; };
enum { I_X = 0, I_GMIX, I_WIN, I_BGATE, I_CONVW, I_CONVB, I_LAM, I_WA, I_BA, I_WX, I_BX, I_SINK, I_WOUT, I_GFFN, I_WFFI, I_WFFO, I_GFIN };

__global__ void __launch_bounds__(NTHR, 2) fwd_kernel(Params P) {
    extern __shared__ __attribute__((aligned(16))) unsigned char lds_raw[];
    LAS unsigned char* lds = (LAS unsigned char*)lds_raw;
    const int tid = threadIdx.x, lane = tid & 63, wave = __builtin_amdgcn_readfirstlane(tid >> 6);
    const int G = gridDim.x, blk = blockIdx.x;
    unsigned char* ws = P.ws;
    bf16* Win_t = (bf16*)(ws + WS_WIN); bf16* Wffi_t = (bf16*)(ws + WS_WFFI); bf16* Wout_t = (bf16*)(ws + WS_WOUT); bf16* Wffo_t = (bf16*)(ws + WS_WFFO); bf16* WG = (bf16*)(ws + WS_WG);
    float* ss0 = (float*)(ws + WS_SS); float* ss1 = ss0 + M_; float* ss2 = ss1 + M_;
    f32x4* cagg = (f32x4*)(ws + WS_CAGG); bf16* VT = (bf16*)(ws + WS_VT); bf16* XB = (bf16*)(ws + WS_XB); bf16* MERGED = XB;
    bf16* PROJ = (bf16*)(ws + WS_PROJ); bf16* X1B = (bf16*)(ws + WS_X1B); bf16* HB = (bf16*)(ws + WS_H);
    const int lo = P.ph_lo, hi = P.ph_hi;
#define IN(k) (lo <= (k) && (k) < hi)
#define SEAM(k) do { if (IN(k) && IN((k) + 1)) cg::this_grid().sync(); } while (0)

    if (IN(0)) {
        LAS float* scr = (LAS float*)(lds + wave * 16384);
        const int gw = blk * NWAVES + wave, NGW = G * NWAVES;
        constexpr int I_A = (D_ / 64) * (INW / 32), I_B = I_A, I_C = (D_ / 64) * (D_ / 32), I_D = (DFF / 64) * (D_ / 32), NITEMS = I_A + I_B + I_C + I_D;
        for (int it = gw; it < NITEMS; it += NGW) {
            int r = it;
            if (r < I_A) { transpose_item<0>(P.in[I_WIN], D_, INW, P.in[I_GMIX], Win_t, scr, r, lane); continue; } r -= I_A;
            if (r < I_B) { transpose_item<1>(P.in[I_WFFI], D_, INW, P.in[I_GFFN], Wffi_t, scr, r, lane); continue; } r -= I_B;
            if (r < I_C) { transpose_item<0>(P.in[I_WOUT], D_, D_, nullptr, Wout_t, scr, r, lane); continue; } r -= I_C;
            transpose_item<0>(P.in[I_WFFO], DFF, D_, nullptr, Wffo_t, scr, r, lane);
        }
        for (int m = gw; m < M_; m += NGW) { const f32x4* xr = (const f32x4*)(P.in[I_X] + (size_t)m * D_) + lane; f32x4 v[4]; float s = 0.f;
#pragma unroll
            for (int jx = 0; jx < 4; ++jx) { v[jx] = xr[64 * jx]; s += (v[jx][0] * v[jx][0] + v[jx][1] * v[jx][1]) + (v[jx][2] * v[jx][2] + v[jx][3] * v[jx][3]); }
            s = wave_sum(s); if (lane == 0) ss0[m] = s;
            u32x2* o8 = (u32x2*)(XB + (size_t)m * D_) + lane;
#pragma unroll
            for (int jx = 0; jx < 4; ++jx) { u32x2 w; w.x = pkbf(v[jx][0], v[jx][1]); w.y = pkbf(v[jx][2], v[jx][3]); o8[64 * jx] = w; } }
        for (int i = blk * NTHR + tid; i < 2 * M_; i += G * NTHR) ss1[i] = 0.f;
        for (int f = blk * NTHR + tid; f < 16 * 4 * 4 * 2 * 64; f += G * NTHR) { const int ln = f & 63, ks = (f >> 6) & 1, n = (f >> 7) & 3, cgx = (f >> 9) & 3, hh = f >> 11;
            const float* src = ((n & 1) ? P.in[I_WX] : P.in[I_WA]) + (size_t)(((n >> 1) * 16 + hh) * 64) * 64; const int col = 16 * cgx + (ln & 15), k0 = 32 * ks + 8 * (ln >> 4);
            u32x4 w; w.x = pkbf(src[(k0 + 0) * 64 + col], src[(k0 + 1) * 64 + col]); w.y = pkbf(src[(k0 + 2) * 64 + col], src[(k0 + 3) * 64 + col]);
            w.z = pkbf(src[(k0 + 4) * 64 + col], src[(k0 + 5) * 64 + col]); w.w = pkbf(src[(k0 + 6) * 64 + col], src[(k0 + 7) * 64 + col]);
            *(u32x4*)(WG + (size_t)f * 8) = w; }
    }
    SEAM(0);
    if (IN(1)) {
        pg8::Gemm g{XB, Win_t, M_, INW, D_}; pg8::StaticOrder S; S.init(M_, INW, G, blk);
        pg8::EpiProj E{PROJ, VT, ss0, QSCALE};
        pg8::gemm_phase<pg8::EpiProj, pg8::StaticOrder, true, true>(lds, g, S, E);
    }
    SEAM(1);
    if (IN(2)) {
        for (int u = blk; u < 1024; u += G) { const int g = u & 3, rest = u >> 2; attn_unit(lds, PROJ, VT, P.in[I_SINK], rest >> 7, g, rest & 127, tid); }
        for (int u = blk; u < 2048; u += G) { const int h = u & 15, rest = u >> 4;
            scan_unit<false>(lds, PROJ, WG, P.in[I_CONVW], P.in[I_CONVB], P.in[I_LAM], P.in[I_BA], P.in[I_BX], P.in[I_BGATE], cagg, MERGED, rest >> 6, rest & 63, h, 0, tid); }
    }
    SEAM(2);
    if (IN(3)) {
        for (int rr = blk; rr < 256; rr += G) { const int b = rr >> 7, h = (rr >> 3) & 15, run = rr & 7, j0 = 8 * run;
            __syncthreads();
            if (wave == 0) { float H = 0.f; LAS float* car = (LAS float*)(lds + SCAR_OFF);
#pragma unroll 8
                for (int jj = 0; jj < j0 + 8; ++jj) { if (jj >= j0) car[(jj - j0) * 128 + lane] = H; const f32x4 v = cagg[(size_t)(b * 64 + jj) * 1024 + 64 * h + lane]; H = v[0] * H + v[1]; } }
            if (wave == 1) { float H = 0.f; LAS float* car = (LAS float*)(lds + SCAR_OFF);
#pragma unroll 8
                for (int jj = 63; jj >= j0; --jj) { if (jj < j0 + 8) car[(jj - j0) * 128 + 64 + lane] = H; const f32x4 v = cagg[(size_t)(b * 64 + jj) * 1024 + 64 * h + lane]; H = v[2] * H + v[3]; } }
            for (int jl = 0; jl < 8; ++jl)
                scan_unit<true>(lds, PROJ, WG, P.in[I_CONVW], P.in[I_CONVB], P.in[I_LAM], P.in[I_BA], P.in[I_BX], P.in[I_BGATE], cagg, MERGED, b, j0 + jl, h, jl, tid);
        }
    }
    SEAM(3);
    if (IN(4)) {
        pg8::Gemm g{MERGED, Wout_t, M_, D_, D_}; pg8::StaticOrder S; S.init(M_, D_, G, blk);
        pg8::EpiResid E{P.in[I_X], P.out, X1B, ss1};
        pg8::gemm_phase<pg8::EpiResid, pg8::StaticOrder, true, true>(lds, g, S, E);
    }
    SEAM(4);
    if (IN(5)) {
        pg8::Gemm g{X1B, Wffi_t, M_, INW, D_}; pg8::StaticOrder S; S.init(M_, INW, G, blk);
        pg8::EpiSwiGLU E{HB, ss1};
        pg8::gemm_phase<pg8::EpiSwiGLU, pg8::StaticOrder, true, true>(lds, g, S, E);
    }
    SEAM(5);
    if (IN(6)) {
        pg8::Gemm g{HB, Wffo_t, M_, D_, DFF}; pg8::StaticOrder S; S.init(M_, D_, G, blk);
        pg8::EpiResid E{P.out, P.out, nullptr, ss2};
        pg8::gemm_phase<pg8::EpiResid, pg8::StaticOrder, true, true>(lds, g, S, E);
    }
    SEAM(6);
    if (IN(7)) {
        const int gw = blk * NWAVES + wave, NGW = G * NWAVES;
        f32x4 gf[4];
#pragma unroll
        for (int jx = 0; jx < 4; ++jx) gf[jx] = ((const f32x4*)P.in[I_GFIN])[lane + 64 * jx];
        for (int m = gw; m < M_; m += NGW) { f32x4* xr = (f32x4*)(P.out + (size_t)m * D_) + lane; const float rs = rsqrtf(ss2[m] * (1.0f / 1024.0f) + 1e-6f);
#pragma unroll
            for (int jx = 0; jx < 4; ++jx) { f32x4 v = xr[64 * jx]; xr[64 * jx] = v * rs * gf[jx]; } }
    }
#undef IN
#undef SEAM
}

extern "C" void kernel_launch(void* const* d_in, const int* in_sizes, int n_in, void* d_out, int out_size, void* d_ws, size_t ws_size, hipStream_t stream) {
    static int grid = 0;
    if (grid == 0) {
        if (n_in != 17 || out_size != M_ * D_ || ws_size < WS_END) { fprintf(stderr, "kernel_launch: unexpected problem (n_in %d, out %d, ws %zu)\n", n_in, out_size, ws_size); grid = -1; return; }
        int dev = 0, cus = 0, per_cu = 0;
        if (hipGetDevice(&dev) != hipSuccess || hipDeviceGetAttribute(&cus, hipDeviceAttributeMultiprocessorCount, dev) != hipSuccess) { grid = -1; return; }
        if (hipFuncSetAttribute((const void*)fwd_kernel, hipFuncAttributeMaxDynamicSharedMemorySize, LDS_BYTES) != hipSuccess) { fprintf(stderr, "kernel_launch: hipFuncSetAttribute failed\n"); grid = -1; return; }
        if (hipOccupancyMaxActiveBlocksPerMultiprocessor(&per_cu, (const void*)fwd_kernel, NTHR, LDS_BYTES) != hipSuccess || per_cu < 1) { fprintf(stderr, "kernel_launch: occupancy query says %d blocks/CU\n", per_cu); grid = -1; return; }
        grid = cus;
    }
    if (grid < 0) return;
    Params p{};
    for (int i = 0; i < 17; ++i) p.in[i] = (const float*)d_in[i];
    p.out = (float*)d_out; p.ws = (unsigned char*)d_ws;
#if MK_LAUNCHES == 1
    p.ph_lo = 0; p.ph_hi = NPH;
    void* args[] = {&p};
    hipError_t e = hipLaunchCooperativeKernel((const void*)fwd_kernel, dim3(grid), dim3(NTHR), args, LDS_BYTES, stream);
    if (e != hipSuccess) fprintf(stderr, "kernel_launch: cooperative launch failed: %s (grid %d)\n", hipGetErrorString(e), grid);
#else
    for (int ph = 0; ph < NPH; ++ph) { p.ph_lo = ph; p.ph_hi = ph + 1; hipLaunchKernelGGL(fwd_kernel, dim3(grid), dim3(NTHR), LDS_BYTES, stream, p); }
#endif
}
```

```cpp
#include <hip/hip_runtime.h>
#include <hip/hip_cooperative_groups.h>
#include <cstdio>
#include <cstdint>
namespace cg = cooperative_groups;
namespace pg8 {
#define PG8_LAS __attribute__((address_space(3)))
typedef unsigned short bf16_t;
typedef short bf16x8 __attribute__((ext_vector_type(8)));
typedef float f32x4 __attribute__((ext_vector_type(4)));
typedef unsigned u32x4 __attribute__((ext_vector_type(4)));
constexpr int BM = 256, BK = 64, HALF = 128, HTB = HALF * BK * 2  , STAGE_BYTES = 8 * HTB, NXCD = 8, WGM = 8;

__host__ __device__ __forceinline__ int lds_byte(int r, int c) { const int st = (r >> 4) * 2 + (c >> 5), rr = r & 15, cc = c & 31, ob = rr * 64 + cc * 2; return st * 1024 + (ob ^ (((ob >> 9) & 1) << 5)); }
__host__ __device__ __forceinline__ void stage_rc(int b, int& R, int& C) { const int st = b / 1024, sb = b % 1024, swz = sb ^ (((sb >> 9) & 1) << 5); R = (st >> 1) * 16 + swz / 64; C = (st & 1) * 32 + (swz % 64) / 2; }
__host__ __device__ __forceinline__ int perm32(int rho) { const int n = rho >> 4, i = rho & 15; return 8 * (i >> 2) + 4 * n + (i & 3); }

struct Unit { int pm, pn; };
struct Gemm { const bf16_t* A; const bf16_t* Bt; int M, N, K; };

struct StaticOrder {
    int nM, nN, nwg, G, c;
    __host__ __device__ void init(int M, int N, int G_, int c_) { nM = M / BM; nN = N / BM; nwg = nM * nN; G = G_; c = c_; }
    __host__ __device__ bool next(int i, Unit& u) const {
        const long L = (long)i * G + c; if (L >= nwg) return false;
        int wgid = (int)L; { const int q = nwg / NXCD, r = nwg % NXCD, xcd = wgid % NXCD, off = wgid / NXCD; wgid = (xcd < r ? xcd * (q + 1) : r * (q + 1) + (xcd - r) * q) + off; }
        const int nig = WGM * nN, gid = wgid / nig, fm = gid * WGM, gsz = (nM - fm) < WGM ? (nM - fm) : WGM;
        u.pm = fm + ((wgid % nig) % gsz); u.pn = (wgid % nig) / gsz; return true;
    }
    __device__ __forceinline__ void a_ready(const Unit&) const {}
    __device__ __forceinline__ void done(const Unit&) const {}
};

__device__ __forceinline__ unsigned cvt_pk_bf16(float lo, float hi) { unsigned r; asm volatile("v_cvt_pk_bf16_f32 %0, %1, %2" : "=v"(r) : "v"(lo), "v"(hi)); return r; }
typedef unsigned u32x2 __attribute__((ext_vector_type(2)));
constexpr float RMS_EPS = 1e-6f;
struct EpiProj {
    static constexpr bool PERM = true, AFTER_DRAIN = false;
    bf16_t* proj; bf16_t* vt; const float* ss; float qscale;
    __device__ __forceinline__ void operator()(const f32x4 (&acc)[2][2][4][2], const Unit& u, int wr, int wc, int fr, int fq) const {
        const int row0 = u.pm * BM + wr * 64 + fr, ct = wc * 32 + 8 * fq;
        const float sc = (u.pn >= 8 && u.pn < 12) ? qscale : 1.f;
        if (u.pn != 13) {
            bf16_t* base = proj + (size_t)u.pn * BM + ct;
#pragma unroll
            for (int ai = 0; ai < 2; ++ai)
#pragma unroll
                for (int m = 0; m < 4; ++m) { const int row = row0 + ai * HALF + m * 16; const float rs = rsqrtf(ss[row] * (1.0f / 1024.0f) + RMS_EPS) * sc;
#pragma unroll
                    for (int bj = 0; bj < 2; ++bj) { const f32x4 v0 = acc[ai][bj][m][0] * rs, v1 = acc[ai][bj][m][1] * rs;
                        u32x4 w; w.x = cvt_pk_bf16(v0[0], v0[1]); w.y = cvt_pk_bf16(v0[2], v0[3]); w.z = cvt_pk_bf16(v1[0], v1[1]); w.w = cvt_pk_bf16(v1[2], v1[3]);
                        *(u32x4*)(base + (size_t)row * 5632 + bj * HALF) = w; } }
        } else {
#pragma unroll
            for (int ai = 0; ai < 2; ++ai)
#pragma unroll
                for (int m = 0; m < 4; ++m) { const int row = row0 + ai * HALF + m * 16; const float rs = rsqrtf(ss[row] * (1.0f / 1024.0f) + RMS_EPS);
                    const int b = row >> 13, s = row & 8191;
#pragma unroll
                    for (int bj = 0; bj < 2; ++bj)
#pragma unroll
                        for (int n = 0; n < 2; ++n) { const f32x4 v = acc[ai][bj][m][n] * rs;
#pragma unroll
                            for (int e = 0; e < 4; ++e) { const int cidx = bj * HALF + ct + 4 * n + e, g = cidx >> 6, d = cidx & 63;
                                vt[(size_t)((b * 4 + g) * 64 + d) * 8192 + s] = (bf16_t)(cvt_pk_bf16(v[e], 0.f) & 0xffffu); } } }
        }
    }
};
struct EpiResid {
    static constexpr bool PERM = false, AFTER_DRAIN = false;
    const float* base; float* out; bf16_t* ob; float* ss;
    __device__ __forceinline__ void operator()(const f32x4 (&acc)[2][2][4][2], const Unit& u, int wr, int wc, int fr, int fq) const {
        const int col0 = u.pn * BM + wc * 32 + 4 * fq;
#pragma unroll
        for (int ai = 0; ai < 2; ++ai)
#pragma unroll
            for (int m = 0; m < 4; ++m) { const int row = u.pm * BM + ai * HALF + wr * 64 + m * 16 + fr; const size_t off = (size_t)row * 1024 + col0; float q = 0.f;
#pragma unroll
                for (int bj = 0; bj < 2; ++bj)
#pragma unroll
                    for (int n = 0; n < 2; ++n) { const size_t o_ = off + bj * HALF + n * 16; const f32x4 bs = *(const f32x4*)(base + o_); const f32x4 o = bs + acc[ai][bj][m][n];
                        *(f32x4*)(out + o_) = o; q += (o[0] * o[0] + o[1] * o[1]) + (o[2] * o[2] + o[3] * o[3]);
                        if (ob) { u32x2 w; w.x = cvt_pk_bf16(o[0], o[1]); w.y = cvt_pk_bf16(o[2], o[3]); *(u32x2*)(ob + o_) = w; } }
                q += __shfl_xor(q, 16); q += __shfl_xor(q, 32);
                if (fq == 0) atomicAdd(ss + row, q);
                if (m & 1) asm volatile("" ::: "memory"); }
    }
};
struct EpiSwiGLU {
    static constexpr bool PERM = true, AFTER_DRAIN = false;
    bf16_t* H; const float* ss;
    __device__ __forceinline__ void operator()(const f32x4 (&acc)[2][2][4][2], const Unit& u, int wr, int wc, int fr, int fq) const {
        const int row0 = u.pm * BM + wr * 64 + fr, col = u.pn * HALF + wc * 32 + 8 * fq;
#pragma unroll
        for (int ai = 0; ai < 2; ++ai)
#pragma unroll
            for (int m = 0; m < 4; ++m) { const int row = row0 + ai * HALF + m * 16; const float rs = rsqrtf(ss[row] * (1.0f / 1024.0f) + RMS_EPS);
                float hv[8];
#pragma unroll
                for (int n = 0; n < 2; ++n) { const f32x4 g = acc[ai][0][m][n] * rs, up = acc[ai][1][m][n] * rs;
#pragma unroll
                    for (int e = 0; e < 4; ++e) { const float sg = __builtin_amdgcn_rcpf(1.f + __builtin_amdgcn_exp2f(-1.4426950408889634f * g[e])); hv[4 * n + e] = g[e] * sg * up[e]; } }
                u32x4 w; w.x = cvt_pk_bf16(hv[0], hv[1]); w.y = cvt_pk_bf16(hv[2], hv[3]); w.z = cvt_pk_bf16(hv[4], hv[5]); w.w = cvt_pk_bf16(hv[6], hv[7]);
                *(u32x4*)(H + (size_t)row * 2816 + col) = w; }
    }
};
template <class Epi, class Sched, bool ALIGN_EPI = false, bool SP2 = false>
__device__ __forceinline__ void gemm_phase(PG8_LAS unsigned char* lds, const Gemm g, const Sched& S, const Epi& E) {
    const int tid = threadIdx.x, wid = __builtin_amdgcn_readfirstlane(tid >> 6), lane = tid & 63, wr = wid >> 2, wc = wid & 3, fr = lane & 15, fq = lane >> 4;
    const int K = g.K, nt = K / BK;
    unsigned voffA[2], voffB[2];
#pragma unroll
    for (int i = 0; i < 2; ++i) { int R, C; stage_rc(tid * 16 + i * 8192, R, C); const int Rb = Epi::PERM ? ((R & ~31) + perm32(R & 31)) : R;
        voffA[i] = (unsigned)(R * K + C) * 2u; voffB[i] = (unsigned)(Rb * K + C) * 2u; }
    const size_t kstep = (size_t)(BK * 2);
    const size_t hstep = (size_t)HALF * K * 2;
    const size_t tstep = 2 * hstep;
    const unsigned ldsw = (unsigned)wid * 1024u;
    const int aoff = lds_byte(wr * 64 + fr, fq * 8), boff = lds_byte(wc * 32 + fr, fq * 8);
#define PG8_SA(b, h) (((b) * 2 + (h)) * HTB)
#define PG8_SB(b, h) ((4 + (b) * 2 + (h)) * HTB)
#define PG8_STAGE(bufoff, gbase, voff) do { _Pragma("unroll") for (int _i = 0; _i < 2; ++_i) \
        __builtin_amdgcn_global_load_lds((const unsigned*)((const char*)(gbase) + (voff)[_i]), (PG8_LAS unsigned*)(lds + (bufoff) + ldsw + _i * 8192), 16, 0, 0); } while (0)
#define PG8_LDA(dst, b, h) do { _Pragma("unroll") for (int m = 0; m < 4; ++m) _Pragma("unroll") for (int k = 0; k < 2; ++k) dst[m][k] = *(const PG8_LAS bf16x8*)(lds + PG8_SA(b, h) + aoff + m * 2048 + k * 1024); } while (0)
#define PG8_LDB(dst, b, h) do { _Pragma("unroll") for (int n = 0; n < 2; ++n) _Pragma("unroll") for (int k = 0; k < 2; ++k) dst[n][k] = *(const PG8_LAS bf16x8*)(lds + PG8_SB(b, h) + boff + n * 2048 + k * 1024); } while (0)
#define PG8_MMA(ai, bj, At, Bt) do { __builtin_amdgcn_s_setprio(1); _Pragma("unroll") for (int m = 0; m < 4; ++m) _Pragma("unroll") for (int n = 0; n < 2; ++n) _Pragma("unroll") for (int k = 0; k < 2; ++k) \
        acc[ai][bj][m][n] = __builtin_amdgcn_mfma_f32_16x16x32_bf16(Bt[n][k], At[m][k], acc[ai][bj][m][n], 0, 0, 0); __builtin_amdgcn_s_setprio(0); } while (0)
#define PG8_WAIT_V(n) asm volatile("s_waitcnt vmcnt(" #n ")" ::: "memory")
#define PG8_WAIT_L(n) asm volatile("s_waitcnt lgkmcnt(" #n ")" ::: "memory")
#define PG8_BAR __builtin_amdgcn_s_barrier()
#define PG8_SCHED __builtin_amdgcn_sched_barrier(0)
    Unit cur, nxt; int ui = 0;
    if (!S.next(0, cur)) return;
    f32x4 acc[2][2][4][2];
#pragma unroll
    for (int a = 0; a < 2; ++a)
#pragma unroll
        for (int b = 0; b < 2; ++b)
#pragma unroll
            for (int m = 0; m < 4; ++m)
#pragma unroll
                for (int n = 0; n < 2; ++n) acc[a][b][m][n] = (f32x4){0.f, 0.f, 0.f, 0.f};
    bf16x8 At[4][2], B0[2][2], B1[2][2];
    const char* cA = (const char*)g.A + (size_t)cur.pm * tstep; const char* cB = (const char*)g.Bt + (size_t)cur.pn * tstep;
    S.a_ready(cur);
    if constexpr (SP2) {
        PG8_STAGE(PG8_SB(0, 0), cB, voffB); PG8_STAGE(PG8_SB(0, 1), cB + hstep, voffB); PG8_STAGE(PG8_SA(0, 0), cA, voffA); PG8_STAGE(PG8_SA(0, 1), cA + hstep, voffA);
        if (wr == 1) PG8_BAR;
        PG8_WAIT_V(2); PG8_BAR;
        PG8_STAGE(PG8_SB(1, 0), cB + kstep, voffB); PG8_STAGE(PG8_SA(1, 0), cA + kstep, voffA); PG8_STAGE(PG8_SB(1, 1), cB + hstep + kstep, voffB);
        PG8_WAIT_V(6); PG8_BAR;
    } else {
        PG8_STAGE(PG8_SB(0, 0), cB, voffB); PG8_STAGE(PG8_SA(0, 0), cA, voffA); PG8_STAGE(PG8_SB(0, 1), cB + hstep, voffB); PG8_STAGE(PG8_SA(0, 1), cA + hstep, voffA);
        if (wr == 1) PG8_BAR;
        PG8_WAIT_V(4); PG8_BAR;
        PG8_STAGE(PG8_SB(1, 0), cB + kstep, voffB); PG8_STAGE(PG8_SA(1, 0), cA + kstep, voffA); PG8_STAGE(PG8_SB(1, 1), cB + hstep + kstep, voffB);
        PG8_WAIT_V(6); PG8_BAR;
    }
    for (;;) {
        const bool has_next = S.next(ui + 1, nxt);
        const char* nA = has_next ? (const char*)g.A + (size_t)nxt.pm * tstep : cA; const char* nB = has_next ? (const char*)g.Bt + (size_t)nxt.pn * tstep : cB;
        for (int t = 0; t < nt; t += 2) {
            const bool last = (t == nt - 2);
            const char* a1 = cA + (size_t)(t + 1) * kstep;
            const char* a2 = last ? nA : cA + (size_t)(t + 2) * kstep; const char* b2 = last ? nB : cB + (size_t)(t + 2) * kstep;
            const char* a3 = a2 + kstep; const char* b3 = b2 + kstep;
            if (last && has_next) S.a_ready(nxt);
            if constexpr (SP2) {
            PG8_LDB(B0, 0, 0); PG8_LDB(B1, 0, 1); PG8_SCHED; PG8_LDA(At, 0, 0); PG8_STAGE(PG8_SA(1, 1), a1 + hstep, voffA);
            PG8_WAIT_V(8); PG8_WAIT_L(0); PG8_BAR; PG8_MMA(0, 0, At, B0); PG8_MMA(0, 1, At, B1); PG8_BAR; PG8_SCHED;
            PG8_LDA(At, 0, 1); PG8_STAGE(PG8_SB(0, 0), b2, voffB); PG8_STAGE(PG8_SB(0, 1), b2 + hstep, voffB); PG8_STAGE(PG8_SA(0, 0), a2, voffA);
            PG8_WAIT_V(8); PG8_WAIT_L(0); PG8_BAR; PG8_MMA(1, 0, At, B0); PG8_MMA(1, 1, At, B1); PG8_BAR; PG8_SCHED;
            PG8_LDB(B0, 1, 0); PG8_LDB(B1, 1, 1); PG8_SCHED; PG8_LDA(At, 1, 0); PG8_STAGE(PG8_SA(0, 1), a2 + hstep, voffA);
            PG8_WAIT_V(8); PG8_WAIT_L(0); PG8_BAR; PG8_MMA(0, 0, At, B0); PG8_MMA(0, 1, At, B1); PG8_BAR; PG8_SCHED;
            PG8_LDA(At, 1, 1); PG8_STAGE(PG8_SB(1, 0), b3, voffB); PG8_STAGE(PG8_SB(1, 1), b3 + hstep, voffB); PG8_STAGE(PG8_SA(1, 0), a3, voffA);
            PG8_WAIT_V(8); PG8_WAIT_L(0); PG8_BAR; PG8_MMA(1, 0, At, B0); PG8_MMA(1, 1, At, B1); PG8_BAR; PG8_SCHED;
            } else {
            PG8_LDB(B0, 0, 0); PG8_SCHED; PG8_LDA(At, 0, 0); PG8_STAGE(PG8_SA(1, 1), a1 + hstep, voffA);
            PG8_WAIT_L(8); PG8_BAR; PG8_WAIT_L(0); PG8_MMA(0, 0, At, B0); PG8_BAR; PG8_SCHED;
            PG8_LDB(B1, 0, 1); PG8_STAGE(PG8_SB(0, 0), b2, voffB);
            PG8_BAR; PG8_WAIT_L(0); PG8_MMA(0, 1, At, B1); PG8_BAR;
            PG8_LDA(At, 0, 1); PG8_STAGE(PG8_SA(0, 0), a2, voffA);
            PG8_BAR; PG8_WAIT_L(0); PG8_MMA(1, 0, At, B0); PG8_BAR; PG8_SCHED;
            PG8_STAGE(PG8_SB(0, 1), b2 + hstep, voffB);
            PG8_WAIT_V(6); PG8_BAR; PG8_MMA(1, 1, At, B1); PG8_BAR;
            PG8_LDB(B0, 1, 0); PG8_SCHED; PG8_LDA(At, 1, 0); PG8_STAGE(PG8_SA(0, 1), a2 + hstep, voffA);
            PG8_WAIT_L(8); PG8_BAR; PG8_WAIT_L(0); PG8_MMA(0, 0, At, B0); PG8_BAR; PG8_SCHED;
            PG8_LDB(B1, 1, 1); PG8_STAGE(PG8_SB(1, 0), b3, voffB);
            PG8_BAR; PG8_WAIT_L(0); PG8_MMA(0, 1, At, B1); PG8_BAR;
            PG8_LDA(At, 1, 1); PG8_STAGE(PG8_SA(1, 0), a3, voffA);
            PG8_BAR; PG8_WAIT_L(0); PG8_MMA(1, 0, At, B0); PG8_BAR; PG8_SCHED;
            PG8_STAGE(PG8_SB(1, 1), b3 + hstep, voffB);
            PG8_WAIT_V(6); PG8_BAR; PG8_MMA(1, 1, At, B1); PG8_BAR;
            }
        }
        if constexpr (ALIGN_EPI) { if (wr == 0) PG8_BAR; }
        if constexpr (!Epi::AFTER_DRAIN) { E(acc, cur, wr, wc, fr, fq); S.done(cur); }
        if (!has_next) break;
#pragma unroll
        for (int a = 0; a < 2; ++a)
#pragma unroll
            for (int b = 0; b < 2; ++b)
#pragma unroll
                for (int m = 0; m < 4; ++m)
#pragma unroll
                    for (int n = 0; n < 2; ++n) acc[a][b][m][n] = (f32x4){0.f, 0.f, 0.f, 0.f};
        cur = nxt; cA = nA; cB = nB; ++ui;
        if constexpr (ALIGN_EPI) { if (wr == 1) PG8_BAR; }
    }
    PG8_WAIT_V(0);
    if constexpr (!ALIGN_EPI) { if (wr == 0) PG8_BAR; }
    PG8_BAR;
    if constexpr (Epi::AFTER_DRAIN) { E.fused(acc, cur, wr, wc, fr, fq, lds, wid, lane); S.done(cur); }
#undef PG8_SA
#undef PG8_SB
#undef PG8_STAGE
#undef PG8_LDA
#undef PG8_LDB
#undef PG8_MMA
#undef PG8_WAIT_V
#undef PG8_WAIT_L
#undef PG8_BAR
#undef PG8_SCHED
}
}
#ifndef MK_LAUNCHES
#define MK_LAUNCHES 1
#endif
#define LAS __attribute__((address_space(3)))
typedef unsigned short bf16;
typedef unsigned u32x4 __attribute__((ext_vector_type(4)));
typedef unsigned u32x2 __attribute__((ext_vector_type(2)));
typedef float f32x4 __attribute__((ext_vector_type(4)));
typedef float f32x2 __attribute__((ext_vector_type(2)));
typedef float f32x16 __attribute__((ext_vector_type(16)));
typedef short bf16x8 __attribute__((ext_vector_type(8)));
typedef __bf16 bf16x2_t __attribute__((ext_vector_type(2)));

constexpr int NWAVES = 8, NTHR = 512, NPH = 8;
constexpr int B_ = 2, S_ = 8192, D_ = 1024, M_ = B_ * S_, INW = 5632, DFF = 2816;
constexpr float LOG2E = 1.4426950408889634f;
constexpr float QSCALE = 0.125f * LOG2E;
constexpr size_t MiB = 1u << 20;
constexpr size_t WS_WIN = 0, WS_WFFI = 11 * MiB, WS_WOUT = 22 * MiB, WS_WFFO = 24 * MiB, WS_WG = 30 * MiB, WS_SS = 31 * MiB, WS_CAGG = 32 * MiB, WS_VT = 34 * MiB,
                 WS_XB = 42 * MiB  , WS_PROJ = 74 * MiB  , WS_X1B = WS_PROJ  , WS_H = 106 * MiB  , WS_END = 250 * MiB;
constexpr size_t WS_BAR = 31 * MiB + 512 * 1024, BAR_BYTES = 16384;
constexpr int LDS_BYTES = 131072 + 1024;

__device__ __forceinline__ float bflo(unsigned w) { return __uint_as_float(w << 16); }
__device__ __forceinline__ float bfhi(unsigned w) { return __uint_as_float(w & 0xffff0000u); }
__device__ __forceinline__ unsigned pkbf(float lo, float hi) { f32x2 v = {lo, hi}; bf16x2_t b = __builtin_convertvector(v, bf16x2_t); return __builtin_bit_cast(unsigned, b); }
__device__ __forceinline__ float ex2(float x) { return __builtin_amdgcn_exp2f(x); }
__device__ __forceinline__ float rcp_(float x) { return __builtin_amdgcn_rcpf(x); }
__device__ __forceinline__ float sigm(float x) { return rcp_(1.f + ex2(-LOG2E * x)); }
__device__ __forceinline__ float wave_sum(float v) {
#pragma unroll
    for (int o = 1; o < 64; o <<= 1) v += __shfl_xor(v, o);
    return v;
}

#define XB_TMO      128
#define XB_XCNT(j)  (256  + 64 * (j))
#define XB_XSUB(j)  (1280 + 64 * (j))
#define XB_XGEN(j)  (2304 + 64 * (j))
#define XB_TOP      3328
#define XB_TOPGEN   3392
#define XCD_BAR_WORDS 3456
#define XB_SPIN_CAP (1u << 18)

__device__ __forceinline__ unsigned xb_ld(unsigned* p)              { return __hip_atomic_load(p, __ATOMIC_RELAXED, __HIP_MEMORY_SCOPE_AGENT); }
__device__ __forceinline__ unsigned xb_add(unsigned* p, unsigned v) { return __hip_atomic_fetch_add(p, v, __ATOMIC_RELAXED, __HIP_MEMORY_SCOPE_AGENT); }
__device__ __forceinline__ unsigned xb_xcc_id() { return (unsigned)__builtin_amdgcn_s_getreg((3 << 11) | 20) & 0xFu; }
#define XB_SPIN(cond, bar) do { unsigned _sp = 0; while (cond) { __builtin_amdgcn_s_sleep(1); \
    if ((++_sp & 255u) == 0u) { if (xb_ld(&(bar)[XB_TMO])) break; if (_sp > XB_SPIN_CAP) { atomicAdd(&(bar)[XB_TMO], 1u); break; } } } } while (0)

struct XcdBarrier {
    unsigned* bar; unsigned x;
    volatile LAS unsigned* st;
};

__device__ __forceinline__ XcdBarrier xcd_barrier_post(unsigned* bar, volatile LAS unsigned* st) {
    XcdBarrier b; b.bar = bar; b.x = xb_xcc_id(); b.st = st;
    if (threadIdx.x == 0) (void)xb_add(&bar[XB_XCNT(b.x)], 1u);
    return b;
}
__device__ __forceinline__ void xcd_barrier_complete(unsigned* bar, unsigned x, unsigned& nloc, unsigned& nx) {
    const unsigned G = gridDim.x * gridDim.y * gridDim.z;
    unsigned sum, cnt, mine, sp = 0u;
    for (;;) {
        sum = 0u; cnt = 0u; mine = 0u;
#pragma unroll
        for (unsigned j = 0; j < 16; ++j) { const unsigned c = xb_ld(&bar[XB_XCNT(j)]); sum += c; cnt += (c > 0u) ? 1u : 0u; mine = (j == x) ? c : mine; }
        if (sum == G) break;
        __builtin_amdgcn_s_sleep(1);
        if ((++sp & 255u) == 0u) { if (xb_ld(&bar[XB_TMO])) break; if (sp > XB_SPIN_CAP) { atomicAdd(&bar[XB_TMO], 1u); break; } }
    }
    nloc = mine > 0u ? mine : 1u; nx = cnt > 0u ? cnt : 1u;
}

__device__ __forceinline__ void xcd_barrier(const XcdBarrier& b) {
    asm volatile("s_waitcnt vmcnt(0)" ::: "memory");
    __syncthreads();
    if (threadIdx.x == 0) {
        unsigned* bar = b.bar;
        __builtin_amdgcn_s_waitcnt(0);
        unsigned nloc = b.st[0], nx = b.st[1];
        if (nloc == 0u) { xcd_barrier_complete(bar, b.x, nloc, nx); b.st[0] = nloc; b.st[1] = nx; }
        const unsigned old = xb_add(&bar[XB_XSUB(b.x)], 1u);
        const unsigned gen = old / nloc;
        if (old + 1u == (gen + 1u) * nloc) {
            __builtin_amdgcn_fence(__ATOMIC_RELEASE, "agent");
            asm volatile("s_waitcnt vmcnt(0)" ::: "memory");
            const unsigned og = xb_add(&bar[XB_TOP], 1u);
            const unsigned tg = og / nx;
            if (og + 1u == (tg + 1u) * nx) xb_add(&bar[XB_TOPGEN], 1u);
            else XB_SPIN(xb_ld(&bar[XB_TOPGEN]) == tg, bar);
            __builtin_amdgcn_fence(__ATOMIC_ACQUIRE, "agent");
            xb_add(&bar[XB_XGEN(b.x)], 1u);
            asm volatile("s_waitcnt vmcnt(0)" ::: "memory");
        } else {
            XB_SPIN(xb_ld(&bar[XB_XGEN(b.x)]) == gen, bar);
            __builtin_amdgcn_fence(__ATOMIC_ACQUIRE, "agent");
            asm volatile("s_waitcnt vmcnt(0)" ::: "memory");
        }
    }
    __syncthreads();
}

template <int MODE>
__device__ __forceinline__ void transpose_item(const float* W, int K, int N, const float* gk, bf16* WT, LAS float* scr, int item, int lane) {
    const int nblk = N / 32, kb = item / nblk, nb = item % nblk, k0 = 64 * kb, n0 = 32 * nb;
#pragma unroll 8
    for (int i = 0; i < 32; ++i) { const int kk = 2 * i + (lane >> 5); float w = W[(size_t)(k0 + kk) * N + n0 + (lane & 31)]; if (gk) w *= gk[k0 + kk]; scr[kk * 33 + (lane & 31)] = w; }
    asm volatile("s_waitcnt lgkmcnt(0)" ::: "memory");
    const int c = lane & 7;
#pragma unroll
    for (int j = 0; j < 4; ++j) { const int n = (lane >> 3) + 8 * j; const LAS float* s = scr + (8 * c) * 33 + n;
        u32x4 o; o.x = pkbf(s[0 * 33], s[1 * 33]); o.y = pkbf(s[2 * 33], s[3 * 33]); o.z = pkbf(s[4 * 33], s[5 * 33]); o.w = pkbf(s[6 * 33], s[7 * 33]);
        const int nn = n0 + n; int drow = nn;
        if (MODE == 1) drow = (nn < DFF) ? ((nn >> 7) * 256 + (nn & 127)) : (((nn - DFF) >> 7) * 256 + 128 + ((nn - DFF) & 127));
        *(u32x4*)(WT + (size_t)drow * K + k0 + 8 * c) = o; }
    asm volatile("s_waitcnt lgkmcnt(0)" ::: "memory");
}

constexpr int KS_OFF = 0, KS_PITCH = 144, VTS_OFF = 320 * KS_PITCH, VTS_PITCH = 656;
__device__ __forceinline__ int crow(int r, int hi) { return (r & 3) + 8 * (r >> 2) + 4 * hi; }
__device__ __forceinline__ void attn_unit(LAS unsigned char* lds, bf16* proj, const bf16* vt, const float* sink, int b, int g, int qb, int tid) {
    const int lane = tid & 63, wave = __builtin_amdgcn_readfirstlane(tid >> 6), r32 = lane & 31, hi = lane >> 5;
    const int q0 = 64 * qb, kb = q0 - 128; const size_t rowbase = (size_t)b * S_;
    for (int id = tid; id < 2560; id += NTHR) { const int kr = id >> 3, c = id & 7, s = kb + kr; u32x4 v = {0u, 0u, 0u, 0u};
        if (s >= 0 && s < S_) v = *(const u32x4*)(proj + (rowbase + s) * INW + 3072 + 64 * g + 8 * c);
        *(LAS u32x4*)(lds + KS_OFF + kr * KS_PITCH + c * 16) = v; }
    for (int id = tid; id < 2560; id += NTHR) { const int d = id / 40, c = id - 40 * d, s = kb + 8 * c; u32x4 v = {0u, 0u, 0u, 0u};
        if (s >= 0 && s < S_) v = *(const u32x4*)(vt + (size_t)((b * 4 + g) * 64 + d) * S_ + s);
        *(LAS u32x4*)(lds + VTS_OFF + d * VTS_PITCH + c * 16) = v; }
    const int hh = 4 * g + (wave >> 1), qh = wave & 1, t = q0 + 32 * qh + r32;
    bf16* qp = proj + (rowbase + t) * INW + 2048 + 64 * hh;
    bf16x8 qf[4];
#pragma unroll
    for (int ds = 0; ds < 4; ++ds) qf[ds] = *(const bf16x8*)(qp + 16 * ds + 8 * hi);
    const float slope2 = exp2f(-0.5f * (float)(hh + 1)) * LOG2E, sink2 = sink[hh] * LOG2E;
    __syncthreads();
    float m = sink2, l = (hi == 0) ? 1.f : 0.f;
    f32x16 o0, o1;
#pragma unroll
    for (int i = 0; i < 16; ++i) { o0[i] = 0.f; o1[i] = 0.f; }
    for (int j = 0; j < 9; ++j) {
        const int kt = 32 * qh + 32 * j;
        f32x16 p;
#pragma unroll
        for (int i = 0; i < 16; ++i) p[i] = 0.f;
#pragma unroll
        for (int ds = 0; ds < 4; ++ds) { const bf16x8 kf = *(const LAS bf16x8*)(lds + KS_OFF + (kt + r32) * KS_PITCH + 32 * ds + 16 * hi);
            p = __builtin_amdgcn_mfma_f32_32x32x16_bf16(kf, qf[ds], p, 0, 0, 0); }
        float mx = -1e30f;
#pragma unroll
        for (int i = 0; i < 16; ++i) { const int kk = crow(i, hi), dist = r32 + 128 - 32 * j - kk, sa = kb + kt + kk;
            const bool valid = (dist <= 128) && (dist >= -128) && (sa >= 0) && (sa < S_);
            const float sc = valid ? (p[i] - slope2 * fabsf((float)dist)) : -1e30f; p[i] = sc; mx = fmaxf(mx, sc); }
        mx = fmaxf(mx, __shfl_xor(mx, 32));
        const float mnew = fmaxf(m, mx), alpha = ex2(m - mnew); m = mnew;
        float rs = 0.f;
#pragma unroll
        for (int i = 0; i < 16; ++i) { p[i] = ex2(p[i] - mnew); rs += p[i]; }
        l = l * alpha + rs;
#pragma unroll
        for (int i = 0; i < 16; ++i) { o0[i] *= alpha; o1[i] *= alpha; }
        u32x4 w0, w1;
        w0.x = pkbf(p[0], p[1]); w0.y = pkbf(p[2], p[3]); w0.z = pkbf(p[4], p[5]); w0.w = pkbf(p[6], p[7]);
        w1.x = pkbf(p[8], p[9]); w1.y = pkbf(p[10], p[11]); w1.z = pkbf(p[12], p[13]); w1.w = pkbf(p[14], p[15]);
        const bf16x8 pb0 = __builtin_bit_cast(bf16x8, w0), pb1 = __builtin_bit_cast(bf16x8, w1);
#pragma unroll
        for (int s = 0; s < 2; ++s) {
            const LAS unsigned char* vp = lds + VTS_OFF + r32 * VTS_PITCH + 2 * (kt + 16 * s + 4 * hi);
            u32x2 a0 = *(const LAS u32x2*)(vp), a1 = *(const LAS u32x2*)(vp + 16);
            u32x2 c0 = *(const LAS u32x2*)(vp + 32 * VTS_PITCH), c1 = *(const LAS u32x2*)(vp + 32 * VTS_PITCH + 16);
            u32x4 va = {a0.x, a0.y, a1.x, a1.y}, vc = {c0.x, c0.y, c1.x, c1.y};
            o0 = __builtin_amdgcn_mfma_f32_32x32x16_bf16(__builtin_bit_cast(bf16x8, va), s == 0 ? pb0 : pb1, o0, 0, 0, 0);
            o1 = __builtin_amdgcn_mfma_f32_32x32x16_bf16(__builtin_bit_cast(bf16x8, vc), s == 0 ? pb0 : pb1, o1, 0, 0, 0);
        }
    }
    l += __shfl_xor(l, 32);
    const float inv = 1.f / l;
#pragma unroll
    for (int g4 = 0; g4 < 4; ++g4) {
        u32x2 w; w.x = pkbf(o0[4 * g4] * inv, o0[4 * g4 + 1] * inv); w.y = pkbf(o0[4 * g4 + 2] * inv, o0[4 * g4 + 3] * inv);
        *(u32x2*)(qp + 8 * g4 + 4 * hi) = w;
        u32x2 w2; w2.x = pkbf(o1[4 * g4] * inv, o1[4 * g4 + 1] * inv); w2.y = pkbf(o1[4 * g4 + 2] * inv, o1[4 * g4 + 3] * inv);
        *(u32x2*)(qp + 32 + 8 * g4 + 4 * hi) = w2;
    }
    __syncthreads();
}

constexpr int SU_OFF = 0, SUCB_OFF = 16896, SUCB_PITCH = 144, SUCF_OFF = 35328, SAGG_OFF = 68608, SCAR_OFF = 76800;
template <bool PASS2>
__device__ __forceinline__ void scan_unit(LAS unsigned char* lds, const bf16* proj, const bf16* wg, const float* conv_w, const float* conv_b, const float* lam, const float* lba, const float* lbx,
                                          const float* b_gate, f32x4* cagg, bf16* merged, int b, int j, int h, int jl, int tid) {
    const int lane = tid & 63, wave = __builtin_amdgcn_readfirstlane(tid >> 6), cg_ = wave & 3, th = wave >> 2, c16 = lane & 15, q = lane >> 4;
    const int t0 = j * 128; const size_t rowbase = (size_t)b * S_;
    for (int id = tid; id < 131 * 8; id += NTHR) { const int rr = id >> 3, c = id & 7, t = t0 - 2 + rr; u32x4 v = {0u, 0u, 0u, 0u};
        if (t >= 0 && t < S_) v = *(const u32x4*)(proj + (rowbase + t) * INW + 64 * h + 8 * c);
        *(LAS u32x4*)(lds + SU_OFF + rr * 128 + c * 16) = v; }
    u32x4 pg[2], pza[2], pzb[2], pyb[2];
    if (PASS2) {
#pragma unroll
        for (int k = 0; k < 2; ++k) { const int id = tid + NTHR * k, tl = id >> 3, c8 = id & 7; const bf16* rp = proj + (rowbase + t0 + tl) * INW + 64 * h + 8 * c8;
            pg[k] = *(const u32x4*)(rp + 1024); pyb[k] = *(const u32x4*)(rp + 2048); pza[k] = *(const u32x4*)(rp + 3584); pzb[k] = *(const u32x4*)(rp + 4608); }
    }
    __syncthreads();
    { const int cp = tid & 31, tg = tid >> 5, ch0 = 64 * h + 2 * cp;
      float w0[4], w1[4];
#pragma unroll
      for (int k = 0; k < 4; ++k) { w0[k] = conv_w[k * 1024 + ch0]; w1[k] = conv_w[k * 1024 + ch0 + 1]; }
      const float bb0 = conv_b[ch0], bb1 = conv_b[ch0 + 1];
      float u0[11], u1[11];
#pragma unroll
      for (int r = 0; r < 11; ++r) { const unsigned w_ = *(const LAS unsigned*)(lds + SU_OFF + (8 * tg + r) * 128 + 4 * cp); u0[r] = bflo(w_); u1[r] = bfhi(w_); }
#pragma unroll
      for (int tt = 0; tt < 8; ++tt) { const float o0 = bb0 + w0[0] * u0[tt] + w0[1] * u0[tt + 1] + w0[2] * u0[tt + 2] + w0[3] * u0[tt + 3];
          const float o1 = bb1 + w1[0] * u1[tt] + w1[1] * u1[tt + 1] + w1[2] * u1[tt + 2] + w1[3] * u1[tt + 3]; const int tl = 8 * tg + tt;
          *(LAS unsigned*)(lds + SUCB_OFF + tl * SUCB_PITCH + 4 * cp) = pkbf(o0, o1);
          LAS float* f = (LAS float*)(lds + SUCF_OFF) + tl * 65 + 2 * cp; f[0] = o0; f[1] = o1; } }
    __syncthreads();
    f32x4 acc[4][4];
#pragma unroll
    for (int mt = 0; mt < 4; ++mt)
#pragma unroll
        for (int n = 0; n < 4; ++n) acc[mt][n] = (f32x4){0.f, 0.f, 0.f, 0.f};
    { bf16x8 bfr[4][2];
#pragma unroll
      for (int n = 0; n < 4; ++n)
#pragma unroll
          for (int ks = 0; ks < 2; ++ks) bfr[n][ks] = *(const bf16x8*)(wg + (size_t)(((((h * 4 + cg_) * 4 + n) * 2 + ks) * 64 + lane)) * 8);
#pragma unroll
      for (int mt = 0; mt < 4; ++mt)
#pragma unroll
          for (int ks = 0; ks < 2; ++ks) { const int trow = 64 * th + 16 * (c16 >> 2) + 4 * mt + (c16 & 3);
              const bf16x8 af = *(const LAS bf16x8*)(lds + SUCB_OFF + trow * SUCB_PITCH + (32 * ks + 8 * q) * 2);
#pragma unroll
              for (int n = 0; n < 4; ++n) acc[mt][n] = __builtin_amdgcn_mfma_f32_16x16x32_bf16(af, bfr[n][ks], acc[mt][n], 0, 0, 0); } }
    const int ch = 16 * cg_ + c16, gch = 64 * h + ch;
    float ba_[2], bx_[2], sp8[2];
#pragma unroll
    for (int d = 0; d < 2; ++d) { ba_[d] = lba[d * 1024 + gch]; bx_[d] = lbx[d * 1024 + gch]; const float z = -lam[d * 1024 + gch]; sp8[d] = 8.f * (fmaxf(z, 0.f) + log1pf(expf(-fabsf(z)))); }
    { const LAS float* ucf = (const LAS float*)(lds + SUCF_OFF) + (64 * th + 16 * q) * 65 + ch;
#pragma unroll
      for (int mt = 0; mt < 4; ++mt)
#pragma unroll
          for (int i = 0; i < 4; ++i) { const float uc = ucf[(4 * mt + i) * 65];
#pragma unroll
              for (int d = 0; d < 2; ++d) { const float r = sigm(acc[mt][2 * d][i] + ba_[d]), ig = sigm(acc[mt][2 * d + 1][i] + bx_[d]);
                  const float la = -r * sp8[d], a = ex2(la * LOG2E), x2 = 2.f * la;
                  const float em = (x2 > -0.1f) ? (-x2 * (1.f + x2 * (0.5f + x2 * (0.16666667f + x2 * 0.041666668f)))) : (1.f - a * a);
                  acc[mt][2 * d][i] = a; acc[mt][2 * d + 1][i] = sqrtf(fmaxf(em, 0.f)) * ig * uc; } } }
    float Af = 1.f, Hf = 0.f, Ab = 1.f, Hb = 0.f;
#pragma unroll
    for (int k = 0; k < 16; ++k) { const float a = acc[k >> 2][0][k & 3]; Hf = a * Hf + acc[k >> 2][1][k & 3]; Af *= a; }
#pragma unroll
    for (int k = 15; k >= 0; --k) { const float a = acc[k >> 2][2][k & 3]; Hb = a * Hb + acc[k >> 2][3][k & 3]; Ab *= a; }
    const int s = 4 * th + q;
    LAS f32x4* AG = (LAS f32x4*)(lds + SAGG_OFF);
    AG[s * 64 + ch] = (f32x4){Af, Hf, Ab, Hb};
    __syncthreads();
    if (!PASS2) {
        if (tid < 64) { float A = 1.f, H = 0.f, A2 = 1.f, H2 = 0.f;
#pragma unroll
            for (int sp = 0; sp < 8; ++sp) { const f32x4 v = AG[sp * 64 + tid]; H = v[0] * H + v[1]; A *= v[0]; }
#pragma unroll
            for (int sp = 7; sp >= 0; --sp) { const f32x4 v = AG[sp * 64 + tid]; H2 = v[2] * H2 + v[3]; A2 *= v[2]; }
            cagg[(size_t)(b * 64 + j) * 1024 + 64 * h + tid] = (f32x4){A, H, A2, H2}; }
    } else {
        const LAS float* car = (const LAS float*)(lds + SCAR_OFF) + jl * 128;
        float cf = car[ch], cb = car[64 + ch];
#pragma unroll
        for (int sp = 0; sp < 8; ++sp) { const f32x4 v = AG[sp * 64 + ch]; if (sp < s) cf = v[0] * cf + v[1]; }
#pragma unroll
        for (int sp = 7; sp >= 0; --sp) { const f32x4 v = AG[sp * 64 + ch]; if (sp > s) cb = v[2] * cb + v[3]; }
        float y[16];
        { float H = cf;
#pragma unroll
          for (int k = 0; k < 16; ++k) { H = acc[k >> 2][0][k & 3] * H + acc[k >> 2][1][k & 3]; y[k] = H; }
          H = cb;
#pragma unroll
          for (int k = 15; k >= 0; --k) { H = acc[k >> 2][2][k & 3] * H + acc[k >> 2][3][k & 3]; y[k] += H; } }
        { LAS float* sy = (LAS float*)(lds + SUCF_OFF) + (64 * th + 16 * q) * 65 + ch;
#pragma unroll
          for (int k = 0; k < 16; ++k) sy[k * 65] = y[k]; }
        __syncthreads();
        const int c8 = tid & 7;
        float bgA[8], bgB[8];
#pragma unroll
        for (int e = 0; e < 8; ++e) { bgA[e] = b_gate[64 * h + 8 * c8 + e]; bgB[e] = b_gate[1024 + 64 * h + 8 * c8 + e]; }
#pragma unroll
        for (int k = 0; k < 2; ++k) { const int id = tid + NTHR * k, tl = id >> 3; const LAS float* sy = (const LAS float*)(lds + SUCF_OFF) + tl * 65 + 8 * c8;
            float mv[8];
#pragma unroll
            for (int e2 = 0; e2 < 4; ++e2) {
                const unsigned gw = pg[k][e2], zaw = pza[k][e2], zbw = pzb[k][e2], ybw = pyb[k][e2];
#pragma unroll
                for (int hf = 0; hf < 2; ++hf) { const int e = 2 * e2 + hf;
                    const float gg = hf ? bfhi(gw) : bflo(gw), za = hf ? bfhi(zaw) : bflo(zaw), zb = hf ? bfhi(zbw) : bflo(zbw), yb = hf ? bfhi(ybw) : bflo(ybw);
                    const float zz = 0.7978845608028654f * (gg + 0.044715f * gg * gg * gg);
                    const float ya = sy[e] * gg * sigm(2.f * zz);
                    mv[e] = sigm(za + bgA[e]) * ya + sigm(zb + bgB[e]) * yb; } }
            u32x4 w; w.x = pkbf(mv[0], mv[1]); w.y = pkbf(mv[2], mv[3]); w.z = pkbf(mv[4], mv[5]); w.w = pkbf(mv[6], mv[7]);
            *(u32x4*)(merged + (rowbase + t0 + tl) * 1024 + 64 * h + 8 * c8) = w; }
    }
}

struct Params { const float* in[17]; float* out; unsigned char* ws; int ph_lo, ph_hi; };
enum { I_X = 0, I_GMIX, I_WIN, I_BGATE, I_CONVW, I_CONVB, I_LAM, I_WA, I_BA, I_WX, I_BX, I_SINK, I_WOUT, I_GFFN, I_WFFI, I_WFFO, I_GFIN };

__global__ void __launch_bounds__(NTHR, 2) fwd_kernel(Params P) {
    extern __shared__ __attribute__((aligned(16))) unsigned char lds_raw[];
    LAS unsigned char* lds = (LAS unsigned char*)lds_raw;
    const int tid = threadIdx.x, lane = tid & 63, wave = __builtin_amdgcn_readfirstlane(tid >> 6);
    const int G = gridDim.x, blk = blockIdx.x;
    unsigned char* ws = P.ws;
    bf16* Win_t = (bf16*)(ws + WS_WIN); bf16* Wffi_t = (bf16*)(ws + WS_WFFI); bf16* Wout_t = (bf16*)(ws + WS_WOUT); bf16* Wffo_t = (bf16*)(ws + WS_WFFO); bf16* WG = (bf16*)(ws + WS_WG);
    float* ss0 = (float*)(ws + WS_SS); float* ss1 = ss0 + M_; float* ss2 = ss1 + M_;
    f32x4* cagg = (f32x4*)(ws + WS_CAGG); bf16* VT = (bf16*)(ws + WS_VT); bf16* XB = (bf16*)(ws + WS_XB); bf16* MERGED = XB;
    bf16* PROJ = (bf16*)(ws + WS_PROJ); bf16* X1B = (bf16*)(ws + WS_X1B); bf16* HB = (bf16*)(ws + WS_H);
    const int lo = P.ph_lo, hi = P.ph_hi;
    volatile LAS unsigned* bst = (volatile LAS unsigned*)(lds + 131072 + 64);
    if (tid < 2) bst[tid] = 0u;
    __syncthreads();
    XcdBarrier bar = xcd_barrier_post((unsigned*)(ws + WS_BAR), bst);
    if (hi - lo > 1) cg::this_grid().sync();
#define IN(k) (lo <= (k) && (k) < hi)
#define SEAM(k) do { if (IN(k) && IN((k) + 1)) xcd_barrier(bar); } while (0)

    if (IN(0)) {
        LAS float* scr = (LAS float*)(lds + wave * 16384);
        const int gw = blk * NWAVES + wave, NGW = G * NWAVES;
        constexpr int I_A = (D_ / 64) * (INW / 32), I_B = I_A, I_C = (D_ / 64) * (D_ / 32), I_D = (DFF / 64) * (D_ / 32), NITEMS = I_A + I_B + I_C + I_D;
        for (int it = gw; it < NITEMS; it += NGW) {
            int r = it;
            if (r < I_A) { transpose_item<0>(P.in[I_WIN], D_, INW, P.in[I_GMIX], Win_t, scr, r, lane); continue; } r -= I_A;
            if (r < I_B) { transpose_item<1>(P.in[I_WFFI], D_, INW, P.in[I_GFFN], Wffi_t, scr, r, lane); continue; } r -= I_B;
            if (r < I_C) { transpose_item<0>(P.in[I_WOUT], D_, D_, nullptr, Wout_t, scr, r, lane); continue; } r -= I_C;
            transpose_item<0>(P.in[I_WFFO], DFF, D_, nullptr, Wffo_t, scr, r, lane);
        }
        for (int m = gw; m < M_; m += NGW) { const f32x4* xr = (const f32x4*)(P.in[I_X] + (size_t)m * D_) + lane; f32x4 v[4]; float s = 0.f;
#pragma unroll
            for (int jx = 0; jx < 4; ++jx) { v[jx] = xr[64 * jx]; s += (v[jx][0] * v[jx][0] + v[jx][1] * v[jx][1]) + (v[jx][2] * v[jx][2] + v[jx][3] * v[jx][3]); }
            s = wave_sum(s); if (lane == 0) ss0[m] = s;
            u32x2* o8 = (u32x2*)(XB + (size_t)m * D_) + lane;
#pragma unroll
            for (int jx = 0; jx < 4; ++jx) { u32x2 w; w.x = pkbf(v[jx][0], v[jx][1]); w.y = pkbf(v[jx][2], v[jx][3]); o8[64 * jx] = w; } }
        for (int i = blk * NTHR + tid; i < 2 * M_; i += G * NTHR) ss1[i] = 0.f;
        for (int f = blk * NTHR + tid; f < 16 * 4 * 4 * 2 * 64; f += G * NTHR) { const int ln = f & 63, ks = (f >> 6) & 1, n = (f >> 7) & 3, cgx = (f >> 9) & 3, hh = f >> 11;
            const float* src = ((n & 1) ? P.in[I_WX] : P.in[I_WA]) + (size_t)(((n >> 1) * 16 + hh) * 64) * 64; const int col = 16 * cgx + (ln & 15), k0 = 32 * ks + 8 * (ln >> 4);
            u32x4 w; w.x = pkbf(src[(k0 + 0) * 64 + col], src[(k0 + 1) * 64 + col]); w.y = pkbf(src[(k0 + 2) * 64 + col], src[(k0 + 3) * 64 + col]);
            w.z = pkbf(src[(k0 + 4) * 64 + col], src[(k0 + 5) * 64 + col]); w.w = pkbf(src[(k0 + 6) * 64 + col], src[(k0 + 7) * 64 + col]);
            *(u32x4*)(WG + (size_t)f * 8) = w; }
    }
    SEAM(0);
    if (IN(1)) {
        pg8::Gemm g{XB, Win_t, M_, INW, D_}; pg8::StaticOrder S; S.init(M_, INW, G, blk);
        pg8::EpiProj E{PROJ, VT, ss0, QSCALE};
        pg8::gemm_phase<pg8::EpiProj, pg8::StaticOrder, true, true>(lds, g, S, E);
    }
    SEAM(1);
    if (IN(2)) {
        for (int u = blk; u < 1024; u += G) { const int g = u & 3, rest = u >> 2; attn_unit(lds, PROJ, VT, P.in[I_SINK], rest >> 7, g, rest & 127, tid); }
        for (int u = blk; u < 2048; u += G) { const int h = u & 15, rest = u >> 4;
            scan_unit<false>(lds, PROJ, WG, P.in[I_CONVW], P.in[I_CONVB], P.in[I_LAM], P.in[I_BA], P.in[I_BX], P.in[I_BGATE], cagg, MERGED, rest >> 6, rest & 63, h, 0, tid); }
    }
    SEAM(2);
    if (IN(3)) {
        for (int rr = blk; rr < 256; rr += G) { const int b = rr >> 7, h = (rr >> 3) & 15, run = rr & 7, j0 = 8 * run;
            __syncthreads();
            if (wave == 0) { float H = 0.f; LAS float* car = (LAS float*)(lds + SCAR_OFF);
#pragma unroll 8
                for (int jj = 0; jj < j0 + 8; ++jj) { if (jj >= j0) car[(jj - j0) * 128 + lane] = H; const f32x4 v = cagg[(size_t)(b * 64 + jj) * 1024 + 64 * h + lane]; H = v[0] * H + v[1]; } }
            if (wave == 1) { float H = 0.f; LAS float* car = (LAS float*)(lds + SCAR_OFF);
#pragma unroll 8
                for (int jj = 63; jj >= j0; --jj) { if (jj < j0 + 8) car[(jj - j0) * 128 + 64 + lane] = H; const f32x4 v = cagg[(size_t)(b * 64 + jj) * 1024 + 64 * h + lane]; H = v[2] * H + v[3]; } }
            for (int jl = 0; jl < 8; ++jl)
                scan_unit<true>(lds, PROJ, WG, P.in[I_CONVW], P.in[I_CONVB], P.in[I_LAM], P.in[I_BA], P.in[I_BX], P.in[I_BGATE], cagg, MERGED, b, j0 + jl, h, jl, tid);
        }
    }
    SEAM(3);
    if (IN(4)) {
        pg8::Gemm g{MERGED, Wout_t, M_, D_, D_}; pg8::StaticOrder S; S.init(M_, D_, G, blk);
        pg8::EpiResid E{P.in[I_X], P.out, X1B, ss1};
        pg8::gemm_phase<pg8::EpiResid, pg8::StaticOrder, true, true>(lds, g, S, E);
    }
    SEAM(4);
    if (IN(5)) {
        pg8::Gemm g{X1B, Wffi_t, M_, INW, D_}; pg8::StaticOrder S; S.init(M_, INW, G, blk);
        pg8::EpiSwiGLU E{HB, ss1};
        pg8::gemm_phase<pg8::EpiSwiGLU, pg8::StaticOrder, true, true>(lds, g, S, E);
    }
    SEAM(5);
    if (IN(6)) {
        pg8::Gemm g{HB, Wffo_t, M_, D_, DFF}; pg8::StaticOrder S; S.init(M_, D_, G, blk);
        pg8::EpiResid E{P.out, P.out, nullptr, ss2};
        pg8::gemm_phase<pg8::EpiResid, pg8::StaticOrder, true, true>(lds, g, S, E);
    }
    SEAM(6);
    if (IN(7)) {
        const int gw = blk * NWAVES + wave, NGW = G * NWAVES;
        f32x4 gf[4];
#pragma unroll
        for (int jx = 0; jx < 4; ++jx) gf[jx] = ((const f32x4*)P.in[I_GFIN])[lane + 64 * jx];
        for (int m = gw; m < M_; m += NGW) { f32x4* xr = (f32x4*)(P.out + (size_t)m * D_) + lane; const float rs = rsqrtf(ss2[m] * (1.0f / 1024.0f) + 1e-6f);
#pragma unroll
            for (int jx = 0; jx < 4; ++jx) { f32x4 v = xr[64 * jx]; xr[64 * jx] = v * rs * gf[jx]; } }
    }
#undef IN
#undef SEAM
}

extern "C" void kernel_launch(void* const* d_in, const int* in_sizes, int n_in, void* d_out, int out_size, void* d_ws, size_t ws_size, hipStream_t stream) {
    static int grid = 0;
    if (grid == 0) {
        if (n_in != 17 || out_size != M_ * D_ || ws_size < WS_END) { fprintf(stderr, "kernel_launch: unexpected problem (n_in %d, out %d, ws %zu)\n", n_in, out_size, ws_size); grid = -1; return; }
        int dev = 0, cus = 0, per_cu = 0;
        if (hipGetDevice(&dev) != hipSuccess || hipDeviceGetAttribute(&cus, hipDeviceAttributeMultiprocessorCount, dev) != hipSuccess) { grid = -1; return; }
        if (hipFuncSetAttribute((const void*)fwd_kernel, hipFuncAttributeMaxDynamicSharedMemorySize, LDS_BYTES) != hipSuccess) { fprintf(stderr, "kernel_launch: hipFuncSetAttribute failed\n"); grid = -1; return; }
        if (hipOccupancyMaxActiveBlocksPerMultiprocessor(&per_cu, (const void*)fwd_kernel, NTHR, LDS_BYTES) != hipSuccess || per_cu < 1) { fprintf(stderr, "kernel_launch: occupancy query says %d blocks/CU\n", per_cu); grid = -1; return; }
        grid = cus;
    }
    if (grid < 0) return;
    if (hipMemsetAsync((char*)d_ws + WS_BAR, 0, BAR_BYTES, stream) != hipSuccess) { fprintf(stderr, "kernel_launch: memset failed\n"); return; }
    Params p{};
    for (int i = 0; i < 17; ++i) p.in[i] = (const float*)d_in[i];
    p.out = (float*)d_out; p.ws = (unsigned char*)d_ws;
#if MK_LAUNCHES == 1
    p.ph_lo = 0; p.ph_hi = NPH;
    void* args[] = {&p};
    hipError_t e = hipLaunchCooperativeKernel((const void*)fwd_kernel, dim3(grid), dim3(NTHR), args, LDS_BYTES, stream);
    if (e != hipSuccess) fprintf(stderr, "kernel_launch: cooperative launch failed: %s (grid %d)\n", hipGetErrorString(e), grid);
#else
    for (int ph = 0; ph < NPH; ++ph) { p.ph_lo = ph; p.ph_hi = ph + 1; hipLaunchKernelGGL(fwd_kernel, dim3(grid), dim3(NTHR), LDS_BYTES, stream, p); }
#endif
}
```

```cpp
#include <hip/hip_runtime.h>
#include <hip/hip_cooperative_groups.h>
#include <cstdio>
#include <cstdint>
namespace cg = cooperative_groups;
namespace pg8 {
#define PG8_LAS __attribute__((address_space(3)))
typedef unsigned short bf16_t;
typedef short bf16x8 __attribute__((ext_vector_type(8)));
typedef float f32x4 __attribute__((ext_vector_type(4)));
typedef unsigned u32x4 __attribute__((ext_vector_type(4)));
constexpr int BM = 256, BK = 64, HALF = 128, HTB = HALF * BK * 2  , STAGE_BYTES = 8 * HTB, NXCD = 8, WGM = 8;

__host__ __device__ __forceinline__ int lds_byte(int r, int c) { const int st = (r >> 4) * 2 + (c >> 5), rr = r & 15, cc = c & 31, ob = rr * 64 + cc * 2; return st * 1024 + (ob ^ (((ob >> 9) & 1) << 5)); }
__host__ __device__ __forceinline__ void stage_rc(int b, int& R, int& C) { const int st = b / 1024, sb = b % 1024, swz = sb ^ (((sb >> 9) & 1) << 5); R = (st >> 1) * 16 + swz / 64; C = (st & 1) * 32 + (swz % 64) / 2; }
__host__ __device__ __forceinline__ int perm32(int rho) { const int n = rho >> 4, i = rho & 15; return 8 * (i >> 2) + 4 * n + (i & 3); }

struct Unit { int pm, pn; };
struct Gemm { const bf16_t* A; const bf16_t* Bt; int M, N, K; };

struct StaticOrder {
    int nM, nN, nwg, G, c;
    __host__ __device__ void init(int M, int N, int G_, int c_) { nM = M / BM; nN = N / BM; nwg = nM * nN; G = G_; c = c_; }
    __host__ __device__ bool next(int i, Unit& u) const {
        const long L = (long)i * G + c; if (L >= nwg) return false;
        int wgid = (int)L; { const int q = nwg / NXCD, r = nwg % NXCD, xcd = wgid % NXCD, off = wgid / NXCD; wgid = (xcd < r ? xcd * (q + 1) : r * (q + 1) + (xcd - r) * q) + off; }
        const int nig = WGM * nN, gid = wgid / nig, fm = gid * WGM, gsz = (nM - fm) < WGM ? (nM - fm) : WGM;
        u.pm = fm + ((wgid % nig) % gsz); u.pn = (wgid % nig) / gsz; return true;
    }
    __device__ __forceinline__ void a_ready(const Unit&) const {}
    __device__ __forceinline__ void done(const Unit&) const {}
};

__device__ __forceinline__ unsigned cvt_pk_bf16(float lo, float hi) { unsigned r; asm volatile("v_cvt_pk_bf16_f32 %0, %1, %2" : "=v"(r) : "v"(lo), "v"(hi)); return r; }
typedef unsigned u32x2 __attribute__((ext_vector_type(2)));
constexpr float RMS_EPS = 1e-6f;
struct EpiProj {
    static constexpr bool PERM = true, AFTER_DRAIN = false;
    bf16_t* proj; bf16_t* vt; const float* ss; float qscale;
    __device__ __forceinline__ void operator()(const f32x4 (&acc)[2][2][4][2], const Unit& u, int wr, int wc, int fr, int fq) const {
        const int row0 = u.pm * BM + wr * 64 + fr, ct = wc * 32 + 8 * fq;
        const float sc = (u.pn >= 8 && u.pn < 12) ? qscale : 1.f;
        if (u.pn != 13) {
            bf16_t* base = proj + (size_t)u.pn * BM + ct;
#pragma unroll
            for (int ai = 0; ai < 2; ++ai)
#pragma unroll
                for (int m = 0; m < 4; ++m) { const int row = row0 + ai * HALF + m * 16; const float rs = rsqrtf(ss[row] * (1.0f / 1024.0f) + RMS_EPS) * sc;
#pragma unroll
                    for (int bj = 0; bj < 2; ++bj) { const f32x4 v0 = acc[ai][bj][m][0] * rs, v1 = acc[ai][bj][m][1] * rs;
                        u32x4 w; w.x = cvt_pk_bf16(v0[0], v0[1]); w.y = cvt_pk_bf16(v0[2], v0[3]); w.z = cvt_pk_bf16(v1[0], v1[1]); w.w = cvt_pk_bf16(v1[2], v1[3]);
                        *(u32x4*)(base + (size_t)row * 5632 + bj * HALF) = w; } }
        } else {
#pragma unroll
            for (int ai = 0; ai < 2; ++ai)
#pragma unroll
                for (int m = 0; m < 4; ++m) { const int row = row0 + ai * HALF + m * 16; const float rs = rsqrtf(ss[row] * (1.0f / 1024.0f) + RMS_EPS);
                    const int b = row >> 13, s = row & 8191;
#pragma unroll
                    for (int bj = 0; bj < 2; ++bj)
#pragma unroll
                        for (int n = 0; n < 2; ++n) { const f32x4 v = acc[ai][bj][m][n] * rs;
#pragma unroll
                            for (int e = 0; e < 4; ++e) { const int cidx = bj * HALF + ct + 4 * n + e, g = cidx >> 6, d = cidx & 63;
                                vt[(size_t)((b * 4 + g) * 64 + d) * 8192 + s] = (bf16_t)(cvt_pk_bf16(v[e], 0.f) & 0xffffu); } } }
        }
    }
};
struct EpiResid {
    static constexpr bool PERM = false, AFTER_DRAIN = false;
    const float* base; float* out; bf16_t* ob; float* ss;
    __device__ __forceinline__ void operator()(const f32x4 (&acc)[2][2][4][2], const Unit& u, int wr, int wc, int fr, int fq) const {
        const int col0 = u.pn * BM + wc * 32 + 4 * fq;
#pragma unroll
        for (int ai = 0; ai < 2; ++ai)
#pragma unroll
            for (int m = 0; m < 4; ++m) { const int row = u.pm * BM + ai * HALF + wr * 64 + m * 16 + fr; const size_t off = (size_t)row * 1024 + col0; float q = 0.f;
#pragma unroll
                for (int bj = 0; bj < 2; ++bj)
#pragma unroll
                    for (int n = 0; n < 2; ++n) { const size_t o_ = off + bj * HALF + n * 16; const f32x4 bs = *(const f32x4*)(base + o_); const f32x4 o = bs + acc[ai][bj][m][n];
                        *(f32x4*)(out + o_) = o; q += (o[0] * o[0] + o[1] * o[1]) + (o[2] * o[2] + o[3] * o[3]);
                        if (ob) { u32x2 w; w.x = cvt_pk_bf16(o[0], o[1]); w.y = cvt_pk_bf16(o[2], o[3]); *(u32x2*)(ob + o_) = w; } }
                q += __shfl_xor(q, 16); q += __shfl_xor(q, 32);
                if (fq == 0) atomicAdd(ss + row, q);
                if (m & 1) asm volatile("" ::: "memory"); }
    }
};
struct EpiSwiGLU {
    static constexpr bool PERM = true, AFTER_DRAIN = false;
    bf16_t* H; const float* ss;
    __device__ __forceinline__ void operator()(const f32x4 (&acc)[2][2][4][2], const Unit& u, int wr, int wc, int fr, int fq) const {
        const int row0 = u.pm * BM + wr * 64 + fr, col = u.pn * HALF + wc * 32 + 8 * fq;
#pragma unroll
        for (int ai = 0; ai < 2; ++ai)
#pragma unroll
            for (int m = 0; m < 4; ++m) { const int row = row0 + ai * HALF + m * 16; const float rs = rsqrtf(ss[row] * (1.0f / 1024.0f) + RMS_EPS);
                float hv[8];
#pragma unroll
                for (int n = 0; n < 2; ++n) { const f32x4 g = acc[ai][0][m][n] * rs, up = acc[ai][1][m][n] * rs;
#pragma unroll
                    for (int e = 0; e < 4; ++e) { const float sg = __builtin_amdgcn_rcpf(1.f + __builtin_amdgcn_exp2f(-1.4426950408889634f * g[e])); hv[4 * n + e] = g[e] * sg * up[e]; } }
                u32x4 w; w.x = cvt_pk_bf16(hv[0], hv[1]); w.y = cvt_pk_bf16(hv[2], hv[3]); w.z = cvt_pk_bf16(hv[4], hv[5]); w.w = cvt_pk_bf16(hv[6], hv[7]);
                *(u32x4*)(H + (size_t)row * 2816 + col) = w; }
    }
};
template <class Epi, class Sched, bool ALIGN_EPI = false, bool SP2 = false>
__device__ __forceinline__ void gemm_phase(PG8_LAS unsigned char* lds, const Gemm g, const Sched& S, const Epi& E) {
    const int tid = threadIdx.x, wid = __builtin_amdgcn_readfirstlane(tid >> 6), lane = tid & 63, wr = wid >> 2, wc = wid & 3, fr = lane & 15, fq = lane >> 4;
    const int K = g.K, nt = K / BK;
    unsigned voffA[2], voffB[2];
#pragma unroll
    for (int i = 0; i < 2; ++i) { int R, C; stage_rc(tid * 16 + i * 8192, R, C); const int Rb = Epi::PERM ? ((R & ~31) + perm32(R & 31)) : R;
        voffA[i] = (unsigned)(R * K + C) * 2u; voffB[i] = (unsigned)(Rb * K + C) * 2u; }
    const size_t kstep = (size_t)(BK * 2);
    const size_t hstep = (size_t)HALF * K * 2;
    const size_t tstep = 2 * hstep;
    const unsigned ldsw = (unsigned)wid * 1024u;
    const int aoff = lds_byte(wr * 64 + fr, fq * 8), boff = lds_byte(wc * 32 + fr, fq * 8);
#define PG8_SA(b, h) (((b) * 2 + (h)) * HTB)
#define PG8_SB(b, h) ((4 + (b) * 2 + (h)) * HTB)
#define PG8_STAGE(bufoff, gbase, voff) do { _Pragma("unroll") for (int _i = 0; _i < 2; ++_i) \
        __builtin_amdgcn_global_load_lds((const unsigned*)((const char*)(gbase) + (voff)[_i]), (PG8_LAS unsigned*)(lds + (bufoff) + ldsw + _i * 8192), 16, 0, 0); } while (0)
#define PG8_LDA(dst, b, h) do { _Pragma("unroll") for (int m = 0; m < 4; ++m) _Pragma("unroll") for (int k = 0; k < 2; ++k) dst[m][k] = *(const PG8_LAS bf16x8*)(lds + PG8_SA(b, h) + aoff + m * 2048 + k * 1024); } while (0)
#define PG8_LDB(dst, b, h) do { _Pragma("unroll") for (int n = 0; n < 2; ++n) _Pragma("unroll") for (int k = 0; k < 2; ++k) dst[n][k] = *(const PG8_LAS bf16x8*)(lds + PG8_SB(b, h) + boff + n * 2048 + k * 1024); } while (0)
#define PG8_MMA(ai, bj, At, Bt) do { __builtin_amdgcn_s_setprio(1); _Pragma("unroll") for (int m = 0; m < 4; ++m) _Pragma("unroll") for (int n = 0; n < 2; ++n) _Pragma("unroll") for (int k = 0; k < 2; ++k) \
        acc[ai][bj][m][n] = __builtin_amdgcn_mfma_f32_16x16x32_bf16(Bt[n][k], At[m][k], acc[ai][bj][m][n], 0, 0, 0); __builtin_amdgcn_s_setprio(0); } while (0)
#define PG8_WAIT_V(n) asm volatile("s_waitcnt vmcnt(" #n ")" ::: "memory")
#define PG8_WAIT_L(n) asm volatile("s_waitcnt lgkmcnt(" #n ")" ::: "memory")
#define PG8_BAR __builtin_amdgcn_s_barrier()
#define PG8_SCHED __builtin_amdgcn_sched_barrier(0)
    Unit cur, nxt; int ui = 0;
    if (!S.next(0, cur)) return;
    f32x4 acc[2][2][4][2];
#pragma unroll
    for (int a = 0; a < 2; ++a)
#pragma unroll
        for (int b = 0; b < 2; ++b)
#pragma unroll
            for (int m = 0; m < 4; ++m)
#pragma unroll
                for (int n = 0; n < 2; ++n) acc[a][b][m][n] = (f32x4){0.f, 0.f, 0.f, 0.f};
    bf16x8 At[4][2], B0[2][2], B1[2][2];
    const char* cA = (const char*)g.A + (size_t)cur.pm * tstep; const char* cB = (const char*)g.Bt + (size_t)cur.pn * tstep;
    S.a_ready(cur);
    if constexpr (SP2) {
        PG8_STAGE(PG8_SB(0, 0), cB, voffB); PG8_STAGE(PG8_SB(0, 1), cB + hstep, voffB); PG8_STAGE(PG8_SA(0, 0), cA, voffA); PG8_STAGE(PG8_SA(0, 1), cA + hstep, voffA);
        if (wr == 1) PG8_BAR;
        PG8_WAIT_V(2); PG8_BAR;
        PG8_STAGE(PG8_SB(1, 0), cB + kstep, voffB); PG8_STAGE(PG8_SA(1, 0), cA + kstep, voffA); PG8_STAGE(PG8_SB(1, 1), cB + hstep + kstep, voffB);
        PG8_WAIT_V(6); PG8_BAR;
    } else {
        PG8_STAGE(PG8_SB(0, 0), cB, voffB); PG8_STAGE(PG8_SA(0, 0), cA, voffA); PG8_STAGE(PG8_SB(0, 1), cB + hstep, voffB); PG8_STAGE(PG8_SA(0, 1), cA + hstep, voffA);
        if (wr == 1) PG8_BAR;
        PG8_WAIT_V(4); PG8_BAR;
        PG8_STAGE(PG8_SB(1, 0), cB + kstep, voffB); PG8_STAGE(PG8_SA(1, 0), cA + kstep, voffA); PG8_STAGE(PG8_SB(1, 1), cB + hstep + kstep, voffB);
        PG8_WAIT_V(6); PG8_BAR;
    }
    for (;;) {
        const bool has_next = S.next(ui + 1, nxt);
        const char* nA = has_next ? (const char*)g.A + (size_t)nxt.pm * tstep : cA; const char* nB = has_next ? (const char*)g.Bt + (size_t)nxt.pn * tstep : cB;
        for (int t = 0; t < nt; t += 2) {
            const bool last = (t == nt - 2);
            const char* a1 = cA + (size_t)(t + 1) * kstep;
            const char* a2 = last ? nA : cA + (size_t)(t + 2) * kstep; const char* b2 = last ? nB : cB + (size_t)(t + 2) * kstep;
            const char* a3 = a2 + kstep; const char* b3 = b2 + kstep;
            if (last && has_next) S.a_ready(nxt);
            if constexpr (SP2) {
            PG8_LDB(B0, 0, 0); PG8_LDB(B1, 0, 1); PG8_SCHED; PG8_LDA(At, 0, 0); PG8_STAGE(PG8_SA(1, 1), a1 + hstep, voffA);
            PG8_WAIT_V(8); PG8_WAIT_L(0); PG8_BAR; PG8_MMA(0, 0, At, B0); PG8_MMA(0, 1, At, B1); PG8_BAR; PG8_SCHED;
            PG8_LDA(At, 0, 1); PG8_STAGE(PG8_SB(0, 0), b2, voffB); PG8_STAGE(PG8_SB(0, 1), b2 + hstep, voffB); PG8_STAGE(PG8_SA(0, 0), a2, voffA);
            PG8_WAIT_V(8); PG8_WAIT_L(0); PG8_BAR; PG8_MMA(1, 0, At, B0); PG8_MMA(1, 1, At, B1); PG8_BAR; PG8_SCHED;
            PG8_LDB(B0, 1, 0); PG8_LDB(B1, 1, 1); PG8_SCHED; PG8_LDA(At, 1, 0); PG8_STAGE(PG8_SA(0, 1), a2 + hstep, voffA);
            PG8_WAIT_V(8); PG8_WAIT_L(0); PG8_BAR; PG8_MMA(0, 0, At, B0); PG8_MMA(0, 1, At, B1); PG8_BAR; PG8_SCHED;
            PG8_LDA(At, 1, 1); PG8_STAGE(PG8_SB(1, 0), b3, voffB); PG8_STAGE(PG8_SB(1, 1), b3 + hstep, voffB); PG8_STAGE(PG8_SA(1, 0), a3, voffA);
            PG8_WAIT_V(8); PG8_WAIT_L(0); PG8_BAR; PG8_MMA(1, 0, At, B0); PG8_MMA(1, 1, At, B1); PG8_BAR; PG8_SCHED;
            } else {
            PG8_LDB(B0, 0, 0); PG8_SCHED; PG8_LDA(At, 0, 0); PG8_STAGE(PG8_SA(1, 1), a1 + hstep, voffA);
            PG8_WAIT_L(8); PG8_BAR; PG8_WAIT_L(0); PG8_MMA(0, 0, At, B0); PG8_BAR; PG8_SCHED;
            PG8_LDB(B1, 0, 1); PG8_STAGE(PG8_SB(0, 0), b2, voffB);
            PG8_BAR; PG8_WAIT_L(0); PG8_MMA(0, 1, At, B1); PG8_BAR;
            PG8_LDA(At, 0, 1); PG8_STAGE(PG8_SA(0, 0), a2, voffA);
            PG8_BAR; PG8_WAIT_L(0); PG8_MMA(1, 0, At, B0); PG8_BAR; PG8_SCHED;
            PG8_STAGE(PG8_SB(0, 1), b2 + hstep, voffB);
            PG8_WAIT_V(6); PG8_BAR; PG8_MMA(1, 1, At, B1); PG8_BAR;
            PG8_LDB(B0, 1, 0); PG8_SCHED; PG8_LDA(At, 1, 0); PG8_STAGE(PG8_SA(0, 1), a2 + hstep, voffA);
            PG8_WAIT_L(8); PG8_BAR; PG8_WAIT_L(0); PG8_MMA(0, 0, At, B0); PG8_BAR; PG8_SCHED;
            PG8_LDB(B1, 1, 1); PG8_STAGE(PG8_SB(1, 0), b3, voffB);
            PG8_BAR; PG8_WAIT_L(0); PG8_MMA(0, 1, At, B1); PG8_BAR;
            PG8_LDA(At, 1, 1); PG8_STAGE(PG8_SA(1, 0), a3, voffA);
            PG8_BAR; PG8_WAIT_L(0); PG8_MMA(1, 0, At, B0); PG8_BAR; PG8_SCHED;
            PG8_STAGE(PG8_SB(1, 1), b3 + hstep, voffB);
            PG8_WAIT_V(6); PG8_BAR; PG8_MMA(1, 1, At, B1); PG8_BAR;
            }
        }
        if constexpr (ALIGN_EPI) { if (wr == 0) PG8_BAR; }
        if constexpr (!Epi::AFTER_DRAIN) { E(acc, cur, wr, wc, fr, fq); S.done(cur); }
        if (!has_next) break;
#pragma unroll
        for (int a = 0; a < 2; ++a)
#pragma unroll
            for (int b = 0; b < 2; ++b)
#pragma unroll
                for (int m = 0; m < 4; ++m)
#pragma unroll
                    for (int n = 0; n < 2; ++n) acc[a][b][m][n] = (f32x4){0.f, 0.f, 0.f, 0.f};
        cur = nxt; cA = nA; cB = nB; ++ui;
        if constexpr (ALIGN_EPI) { if (wr == 1) PG8_BAR; }
    }
    PG8_WAIT_V(0);
    if constexpr (!ALIGN_EPI) { if (wr == 0) PG8_BAR; }
    PG8_BAR;
    if constexpr (Epi::AFTER_DRAIN) { E.fused(acc, cur, wr, wc, fr, fq, lds, wid, lane); S.done(cur); }
#undef PG8_SA
#undef PG8_SB
#undef PG8_STAGE
#undef PG8_LDA
#undef PG8_LDB
#undef PG8_MMA
#undef PG8_WAIT_V
#undef PG8_WAIT_L
#undef PG8_BAR
#undef PG8_SCHED
}
}
#ifndef MK_LAUNCHES
#define MK_LAUNCHES 1
#endif
#define LAS __attribute__((address_space(3)))
typedef unsigned short bf16;
typedef unsigned u32x4 __attribute__((ext_vector_type(4)));
typedef unsigned u32x2 __attribute__((ext_vector_type(2)));
typedef float f32x4 __attribute__((ext_vector_type(4)));
typedef float f32x2 __attribute__((ext_vector_type(2)));
typedef float f32x16 __attribute__((ext_vector_type(16)));
typedef short bf16x8 __attribute__((ext_vector_type(8)));
typedef __bf16 bf16x2_t __attribute__((ext_vector_type(2)));

constexpr int NWAVES = 8, NTHR = 512, NPH = 8;
constexpr int B_ = 2, S_ = 8192, D_ = 1024, M_ = B_ * S_, INW = 5632, DFF = 2816;
constexpr float LOG2E = 1.4426950408889634f;
constexpr float QSCALE = 0.125f * LOG2E;
constexpr size_t MiB = 1u << 20;
constexpr size_t WS_WIN = 0, WS_WFFI = 11 * MiB, WS_WOUT = 22 * MiB, WS_WFFO = 24 * MiB, WS_WG = 30 * MiB, WS_SS = 31 * MiB, WS_CAGG = 32 * MiB, WS_VT = 34 * MiB,
                 WS_XB = 42 * MiB  , WS_PROJ = 74 * MiB  , WS_X1B = WS_PROJ  , WS_H = 106 * MiB  , WS_END = 250 * MiB;
constexpr size_t WS_BAR = 31 * MiB + 512 * 1024, BAR_BYTES = 16384;
constexpr int LDS_BYTES = 131072 + 1024;

__device__ __forceinline__ float bflo(unsigned w) { return __uint_as_float(w << 16); }
__device__ __forceinline__ float bfhi(unsigned w) { return __uint_as_float(w & 0xffff0000u); }
__device__ __forceinline__ unsigned pkbf(float lo, float hi) { f32x2 v = {lo, hi}; bf16x2_t b = __builtin_convertvector(v, bf16x2_t); return __builtin_bit_cast(unsigned, b); }
__device__ __forceinline__ float ex2(float x) { return __builtin_amdgcn_exp2f(x); }
__device__ __forceinline__ float rcp_(float x) { return __builtin_amdgcn_rcpf(x); }
__device__ __forceinline__ float sigm(float x) { return rcp_(1.f + ex2(-LOG2E * x)); }
__device__ __forceinline__ float wave_sum(float v) {
#pragma unroll
    for (int o = 1; o < 64; o <<= 1) v += __shfl_xor(v, o);
    return v;
}

#define XB_TMO      128
#define XB_XCNT(j)  (256  + 64 * (j))
#define XB_XSUB(j)  (1280 + 64 * (j))
#define XB_XGEN(j)  (2304 + 64 * (j))
#define XB_TOP      3328
#define XB_TOPGEN   3392
#define XCD_BAR_WORDS 3456
#define XB_SPIN_CAP (1u << 18)

__device__ __forceinline__ unsigned xb_ld(unsigned* p)              { return __hip_atomic_load(p, __ATOMIC_RELAXED, __HIP_MEMORY_SCOPE_AGENT); }
__device__ __forceinline__ unsigned xb_add(unsigned* p, unsigned v) { return __hip_atomic_fetch_add(p, v, __ATOMIC_RELAXED, __HIP_MEMORY_SCOPE_AGENT); }
__device__ __forceinline__ unsigned xb_xcc_id() { return (unsigned)__builtin_amdgcn_s_getreg((3 << 11) | 20) & 0xFu; }
#define XB_SPIN(cond, bar) do { unsigned _sp = 0; while (cond) { __builtin_amdgcn_s_sleep(1); \
    if ((++_sp & 255u) == 0u) { if (xb_ld(&(bar)[XB_TMO])) break; if (_sp > XB_SPIN_CAP) { atomicAdd(&(bar)[XB_TMO], 1u); break; } } } } while (0)

struct XcdBarrier {
    unsigned* bar; unsigned x;
    volatile LAS unsigned* st;
};

__device__ __forceinline__ XcdBarrier xcd_barrier_post(unsigned* bar, volatile LAS unsigned* st) {
    XcdBarrier b; b.bar = bar; b.x = xb_xcc_id(); b.st = st;
    if (threadIdx.x == 0) (void)xb_add(&bar[XB_XCNT(b.x)], 1u);
    return b;
}
__device__ __forceinline__ void xcd_barrier_complete(unsigned* bar, unsigned x, unsigned& nloc, unsigned& nx) {
    const unsigned G = gridDim.x * gridDim.y * gridDim.z;
    unsigned sum, cnt, mine, sp = 0u;
    for (;;) {
        sum = 0u; cnt = 0u; mine = 0u;
#pragma unroll
        for (unsigned j = 0; j < 16; ++j) { const unsigned c = xb_ld(&bar[XB_XCNT(j)]); sum += c; cnt += (c > 0u) ? 1u : 0u; mine = (j == x) ? c : mine; }
        if (sum == G) break;
        __builtin_amdgcn_s_sleep(1);
        if ((++sp & 255u) == 0u) { if (xb_ld(&bar[XB_TMO])) break; if (sp > XB_SPIN_CAP) { atomicAdd(&bar[XB_TMO], 1u); break; } }
    }
    nloc = mine > 0u ? mine : 1u; nx = cnt > 0u ? cnt : 1u;
}

__device__ __forceinline__ void xcd_barrier(const XcdBarrier& b) {
    asm volatile("s_waitcnt vmcnt(0)" ::: "memory");
    __syncthreads();
    if (threadIdx.x == 0) {
        unsigned* bar = b.bar;
        __builtin_amdgcn_s_waitcnt(0);
        unsigned nloc = b.st[0], nx = b.st[1];
        if (nloc == 0u) { xcd_barrier_complete(bar, b.x, nloc, nx); b.st[0] = nloc; b.st[1] = nx; }
        const unsigned old = xb_add(&bar[XB_XSUB(b.x)], 1u);
        const unsigned gen = old / nloc;
        if (old + 1u == (gen + 1u) * nloc) {
            __builtin_amdgcn_fence(__ATOMIC_RELEASE, "agent");
            asm volatile("s_waitcnt vmcnt(0)" ::: "memory");
            const unsigned og = xb_add(&bar[XB_TOP], 1u);
            const unsigned tg = og / nx;
            if (og + 1u == (tg + 1u) * nx) xb_add(&bar[XB_TOPGEN], 1u);
            else XB_SPIN(xb_ld(&bar[XB_TOPGEN]) == tg, bar);
            __builtin_amdgcn_fence(__ATOMIC_ACQUIRE, "agent");
            xb_add(&bar[XB_XGEN(b.x)], 1u);
            asm volatile("s_waitcnt vmcnt(0)" ::: "memory");
        } else {
            XB_SPIN(xb_ld(&bar[XB_XGEN(b.x)]) == gen, bar);
            __builtin_amdgcn_fence(__ATOMIC_ACQUIRE, "agent");
            asm volatile("s_waitcnt vmcnt(0)" ::: "memory");
        }
    }
    __syncthreads();
}

template <int MODE>
__device__ __forceinline__ void transpose_item(const float* W, int K, int N, const float* gk, bf16* WT, LAS float* scr, int item, int lane) {
    const int nblk = N / 32, kb = item / nblk, nb = item % nblk, k0 = 64 * kb, n0 = 32 * nb;
#pragma unroll 8
    for (int i = 0; i < 32; ++i) { const int kk = 2 * i + (lane >> 5); float w = W[(size_t)(k0 + kk) * N + n0 + (lane & 31)]; if (gk) w *= gk[k0 + kk]; scr[kk * 33 + (lane & 31)] = w; }
    asm volatile("s_waitcnt lgkmcnt(0)" ::: "memory");
    const int c = lane & 7;
#pragma unroll
    for (int j = 0; j < 4; ++j) { const int n = (lane >> 3) + 8 * j; const LAS float* s = scr + (8 * c) * 33 + n;
        u32x4 o; o.x = pkbf(s[0 * 33], s[1 * 33]); o.y = pkbf(s[2 * 33], s[3 * 33]); o.z = pkbf(s[4 * 33], s[5 * 33]); o.w = pkbf(s[6 * 33], s[7 * 33]);
        const int nn = n0 + n; int drow = nn;
        if (MODE == 1) drow = (nn < DFF) ? ((nn >> 7) * 256 + (nn & 127)) : (((nn - DFF) >> 7) * 256 + 128 + ((nn - DFF) & 127));
        *(u32x4*)(WT + (size_t)drow * K + k0 + 8 * c) = o; }
    asm volatile("s_waitcnt lgkmcnt(0)" ::: "memory");
}

constexpr int KS_OFF = 0, KS_PITCH = 144, VTS_OFF = 320 * KS_PITCH, VTS_PITCH = 656;
__device__ __forceinline__ int crow(int r, int hi) { return (r & 3) + 8 * (r >> 2) + 4 * hi; }
__device__ __forceinline__ void attn_unit(LAS unsigned char* lds, bf16* proj, const bf16* vt, const float* sink, int b, int g, int qb, int tid) {
    const int lane = tid & 63, wave = __builtin_amdgcn_readfirstlane(tid >> 6), r32 = lane & 31, hi = lane >> 5;
    const int q0 = 64 * qb, kb = q0 - 128; const size_t rowbase = (size_t)b * S_;
    for (int id = tid; id < 2560; id += NTHR) { const int kr = id >> 3, c = id & 7, s = kb + kr; u32x4 v = {0u, 0u, 0u, 0u};
        if (s >= 0 && s < S_) v = *(const u32x4*)(proj + (rowbase + s) * INW + 3072 + 64 * g + 8 * c);
        *(LAS u32x4*)(lds + KS_OFF + kr * KS_PITCH + c * 16) = v; }
    for (int id = tid; id < 2560; id += NTHR) { const int d = id / 40, c = id - 40 * d, s = kb + 8 * c; u32x4 v = {0u, 0u, 0u, 0u};
        if (s >= 0 && s < S_) v = *(const u32x4*)(vt + (size_t)((b * 4 + g) * 64 + d) * S_ + s);
        *(LAS u32x4*)(lds + VTS_OFF + d * VTS_PITCH + c * 16) = v; }
    const int hh = 4 * g + (wave >> 1), qh = wave & 1, t = q0 + 32 * qh + r32;
    bf16* qp = proj + (rowbase + t) * INW + 2048 + 64 * hh;
    bf16x8 qf[4];
#pragma unroll
    for (int ds = 0; ds < 4; ++ds) qf[ds] = *(const bf16x8*)(qp + 16 * ds + 8 * hi);
    const float slope2 = exp2f(-0.5f * (float)(hh + 1)) * LOG2E, sink2 = sink[hh] * LOG2E;
    __syncthreads();
    float m = sink2, l = (hi == 0) ? 1.f : 0.f;
    f32x16 o0, o1;
#pragma unroll
    for (int i = 0; i < 16; ++i) { o0[i] = 0.f; o1[i] = 0.f; }
    for (int j = 0; j < 9; ++j) {
        const int kt = 32 * qh + 32 * j;
        f32x16 p;
#pragma unroll
        for (int i = 0; i < 16; ++i) p[i] = 0.f;
#pragma unroll
        for (int ds = 0; ds < 4; ++ds) { const bf16x8 kf = *(const LAS bf16x8*)(lds + KS_OFF + (kt + r32) * KS_PITCH + 32 * ds + 16 * hi);
            p = __builtin_amdgcn_mfma_f32_32x32x16_bf16(kf, qf[ds], p, 0, 0, 0); }
        float mx = -1e30f;
#pragma unroll
        for (int i = 0; i < 16; ++i) { const int kk = crow(i, hi), dist = r32 + 128 - 32 * j - kk, sa = kb + kt + kk;
            const bool valid = (dist <= 128) && (dist >= -128) && (sa >= 0) && (sa < S_);
            const float sc = valid ? (p[i] - slope2 * fabsf((float)dist)) : -1e30f; p[i] = sc; mx = fmaxf(mx, sc); }
        mx = fmaxf(mx, __shfl_xor(mx, 32));
        const float mnew = fmaxf(m, mx), alpha = ex2(m - mnew); m = mnew;
        float rs = 0.f;
#pragma unroll
        for (int i = 0; i < 16; ++i) { p[i] = ex2(p[i] - mnew); rs += p[i]; }
        l = l * alpha + rs;
#pragma unroll
        for (int i = 0; i < 16; ++i) { o0[i] *= alpha; o1[i] *= alpha; }
        u32x4 w0, w1;
        w0.x = pkbf(p[0], p[1]); w0.y = pkbf(p[2], p[3]); w0.z = pkbf(p[4], p[5]); w0.w = pkbf(p[6], p[7]);
        w1.x = pkbf(p[8], p[9]); w1.y = pkbf(p[10], p[11]); w1.z = pkbf(p[12], p[13]); w1.w = pkbf(p[14], p[15]);
        const bf16x8 pb0 = __builtin_bit_cast(bf16x8, w0), pb1 = __builtin_bit_cast(bf16x8, w1);
#pragma unroll
        for (int s = 0; s < 2; ++s) {
            const LAS unsigned char* vp = lds + VTS_OFF + r32 * VTS_PITCH + 2 * (kt + 16 * s + 4 * hi);
            u32x2 a0 = *(const LAS u32x2*)(vp), a1 = *(const LAS u32x2*)(vp + 16);
            u32x2 c0 = *(const LAS u32x2*)(vp + 32 * VTS_PITCH), c1 = *(const LAS u32x2*)(vp + 32 * VTS_PITCH + 16);
            u32x4 va = {a0.x, a0.y, a1.x, a1.y}, vc = {c0.x, c0.y, c1.x, c1.y};
            o0 = __builtin_amdgcn_mfma_f32_32x32x16_bf16(__builtin_bit_cast(bf16x8, va), s == 0 ? pb0 : pb1, o0, 0, 0, 0);
            o1 = __builtin_amdgcn_mfma_f32_32x32x16_bf16(__builtin_bit_cast(bf16x8, vc), s == 0 ? pb0 : pb1, o1, 0, 0, 0);
        }
    }
    l += __shfl_xor(l, 32);
    const float inv = 1.f / l;
#pragma unroll
    for (int g4 = 0; g4 < 4; ++g4) {
        u32x2 w; w.x = pkbf(o0[4 * g4] * inv, o0[4 * g4 + 1] * inv); w.y = pkbf(o0[4 * g4 + 2] * inv, o0[4 * g4 + 3] * inv);
        *(u32x2*)(qp + 8 * g4 + 4 * hi) = w;
        u32x2 w2; w2.x = pkbf(o1[4 * g4] * inv, o1[4 * g4 + 1] * inv); w2.y = pkbf(o1[4 * g4 + 2] * inv, o1[4 * g4 + 3] * inv);
        *(u32x2*)(qp + 32 + 8 * g4 + 4 * hi) = w2;
    }
    __syncthreads();
}

constexpr int SU_OFF = 0, SUCB_OFF = 16896, SUCB_PITCH = 144, SUCF_OFF = 35328, SAGG_OFF = 68608, SCAR_OFF = 76800, SBG_OFF = 80896, SCW_OFF = 81408, SWG_OFF = 82688;
template <bool PASS2>
__device__ __forceinline__ void scan_run(LAS unsigned char* lds, const bf16* proj, const bf16* wg, const float* conv_w, const float* conv_b, const float* lam, const float* lba, const float* lbx,
                                         const float* b_gate, f32x4* cagg, bf16* merged, int b, int h, int j0, int tid) {
    const int lane = tid & 63, wave = __builtin_amdgcn_readfirstlane(tid >> 6), cg_ = wave & 3, th = wave >> 2, c16 = lane & 15, q = lane >> 4;
    const size_t rowbase = (size_t)b * S_;
    u32x4 pu[3];
#define SC_LOAD_U(jj) do { _Pragma("unroll") for (int k_ = 0; k_ < 3; ++k_) { const int id_ = tid + NTHR * k_; pu[k_] = (u32x4){0u, 0u, 0u, 0u}; \
        if (id_ < 131 * 8) { const int rr_ = id_ >> 3, c_ = id_ & 7, t_ = (jj) * 128 - 2 + rr_; if (t_ >= 0 && t_ < S_) pu[k_] = *(const u32x4*)(proj + (rowbase + t_) * INW + 64 * h + 8 * c_); } } } while (0)
#define SC_STORE_U() do { _Pragma("unroll") for (int k_ = 0; k_ < 3; ++k_) { const int id_ = tid + NTHR * k_; if (id_ < 131 * 8) *(LAS u32x4*)(lds + SU_OFF + (id_ >> 3) * 128 + (id_ & 7) * 16) = pu[k_]; } } while (0)
    SC_LOAD_U(j0);
#pragma unroll
    for (int k = 0; k < 4; ++k) { const int id = tid + NTHR * k; *(LAS u32x4*)(lds + SWG_OFF + id * 16) = *(const u32x4*)(wg + (size_t)h * 16384 + id * 8); }
    const int ch = 16 * cg_ + c16, gch = 64 * h + ch;
    float ba_[2], bx_[2], sp8[2];
#pragma unroll
    for (int d = 0; d < 2; ++d) { ba_[d] = -LOG2E * lba[d * 1024 + gch]; bx_[d] = -LOG2E * lbx[d * 1024 + gch]; const float z = -lam[d * 1024 + gch]; sp8[d] = 8.f * (fmaxf(z, 0.f) + log1pf(expf(-fabsf(z)))); }
    const int cp = tid & 31, tg = tid >> 5;
    const int c8 = tid & 7;
    if (tid < 64) { LAS float* cw = (LAS float*)(lds + SCW_OFF);
#pragma unroll
        for (int k = 0; k < 4; ++k) cw[k * 64 + tid] = conv_w[k * 1024 + 64 * h + tid];
        cw[4 * 64 + tid] = conv_b[64 * h + tid];
        if (PASS2) { LAS float* bg = (LAS float*)(lds + SBG_OFF); bg[tid] = -LOG2E * b_gate[64 * h + tid]; bg[64 + tid] = -LOG2E * b_gate[1024 + 64 * h + tid]; } }
    if (PASS2) {
        if (wave == 0) { float H = 0.f; LAS float* car = (LAS float*)(lds + SCAR_OFF);
#pragma unroll 8
            for (int jj = 0; jj < j0 + 8; ++jj) { if (jj >= j0) car[(jj - j0) * 128 + lane] = H; const f32x4 v = cagg[(size_t)(b * 64 + jj) * 1024 + 64 * h + lane]; H = v[0] * H + v[1]; } }
        if (wave == 1) { float H = 0.f; LAS float* car = (LAS float*)(lds + SCAR_OFF);
#pragma unroll 8
            for (int jj = 63; jj >= j0; --jj) { if (jj < j0 + 8) car[(jj - j0) * 128 + 64 + lane] = H; const f32x4 v = cagg[(size_t)(b * 64 + jj) * 1024 + 64 * h + lane]; H = v[2] * H + v[3]; } }
    }
    for (int jl = 0; jl < 8; ++jl) {
        const int j = j0 + jl, t0 = j * 128;
        SC_STORE_U();
        if (jl < 7) SC_LOAD_U(j + 1);
        u32x4 pg[2], pza[2], pzb[2], pyb[2];
        if (PASS2) {
#pragma unroll
            for (int k = 0; k < 2; ++k) { const int id = tid + NTHR * k, tl = id >> 3; const bf16* rp = proj + (rowbase + t0 + tl) * INW + 64 * h + 8 * c8;
                pg[k] = *(const u32x4*)(rp + 1024); pyb[k] = *(const u32x4*)(rp + 2048); pza[k] = *(const u32x4*)(rp + 3584); pzb[k] = *(const u32x4*)(rp + 4608); }
        }
        __syncthreads();
        { float u0[11], u1[11], w0[4], w1[4]; const LAS float* cw = (const LAS float*)(lds + SCW_OFF) + 2 * cp;
#pragma unroll
          for (int k = 0; k < 4; ++k) { w0[k] = cw[k * 64]; w1[k] = cw[k * 64 + 1]; }
          const float bb0 = cw[4 * 64], bb1 = cw[4 * 64 + 1];
#pragma unroll
          for (int r = 0; r < 11; ++r) { const unsigned w_ = *(const LAS unsigned*)(lds + SU_OFF + (8 * tg + r) * 128 + 4 * cp); u0[r] = bflo(w_); u1[r] = bfhi(w_); }
#pragma unroll
          for (int tt = 0; tt < 8; ++tt) { const float o0 = bb0 + w0[0] * u0[tt] + w0[1] * u0[tt + 1] + w0[2] * u0[tt + 2] + w0[3] * u0[tt + 3];
              const float o1 = bb1 + w1[0] * u1[tt] + w1[1] * u1[tt + 1] + w1[2] * u1[tt + 2] + w1[3] * u1[tt + 3]; const int tl = 8 * tg + tt;
              *(LAS unsigned*)(lds + SUCB_OFF + tl * SUCB_PITCH + 4 * cp) = pkbf(o0, o1);
              LAS float* f = (LAS float*)(lds + SUCF_OFF) + tl * 65 + 2 * cp; f[0] = o0; f[1] = o1; } }
        __syncthreads();
        f32x4 acc[4][4];
#pragma unroll
        for (int mt = 0; mt < 4; ++mt)
#pragma unroll
            for (int n = 0; n < 4; ++n) acc[mt][n] = (f32x4){0.f, 0.f, 0.f, 0.f};
#pragma unroll
        for (int ks = 0; ks < 2; ++ks) { bf16x8 af[4];
#pragma unroll
            for (int mt = 0; mt < 4; ++mt) { const int trow = 64 * th + 16 * (c16 >> 2) + 4 * mt + (c16 & 3); af[mt] = *(const LAS bf16x8*)(lds + SUCB_OFF + trow * SUCB_PITCH + (32 * ks + 8 * q) * 2); }
#pragma unroll
            for (int n = 0; n < 4; ++n) { const bf16x8 bfr = *(const LAS bf16x8*)(lds + SWG_OFF + (((cg_ * 4 + n) * 2 + ks) * 64 + lane) * 16);
#pragma unroll
                for (int mt = 0; mt < 4; ++mt) acc[mt][n] = __builtin_amdgcn_mfma_f32_16x16x32_bf16(af[mt], bfr, acc[mt][n], 0, 0, 0); } }
        { const LAS float* ucf = (const LAS float*)(lds + SUCF_OFF) + (64 * th + 16 * q) * 65 + ch;
#pragma unroll
          for (int mt = 0; mt < 4; ++mt)
#pragma unroll
              for (int i = 0; i < 4; ++i) { const float uc = ucf[(4 * mt + i) * 65];
#pragma unroll
                  for (int d = 0; d < 2; ++d) { const float e1 = ex2(-LOG2E * acc[mt][2 * d][i] + ba_[d]), e2 = ex2(-LOG2E * acc[mt][2 * d + 1][i] + bx_[d]);
                      const float r = rcp_(1.f + e1), la = -r * sp8[d], a = ex2(la * LOG2E), x2 = 2.f * la, p2 = 1.f + e2;
                      const float em = (x2 > -0.1f) ? (-x2 * (1.f + x2 * (0.5f + x2 * (0.16666667f + x2 * 0.041666668f)))) : (1.f - a * a);
                      const float bi = em * __builtin_amdgcn_rsqf(fmaxf(em * p2 * p2, 1e-37f));
                      acc[mt][2 * d][i] = a; acc[mt][2 * d + 1][i] = bi * uc; } } }
        float Af = 1.f, Hf = 0.f, Ab = 1.f, Hb = 0.f;
#pragma unroll
        for (int k = 0; k < 16; ++k) { const float a = acc[k >> 2][0][k & 3]; Hf = a * Hf + acc[k >> 2][1][k & 3]; Af *= a; }
#pragma unroll
        for (int k = 15; k >= 0; --k) { const float a = acc[k >> 2][2][k & 3]; Hb = a * Hb + acc[k >> 2][3][k & 3]; Ab *= a; }
        const int s = 4 * th + q;
        LAS f32x4* AG = (LAS f32x4*)(lds + SAGG_OFF);
        AG[s * 64 + ch] = (f32x4){Af, Hf, Ab, Hb};
        __syncthreads();
        if (!PASS2) {
            if (tid < 64) { float A = 1.f, H = 0.f, A2 = 1.f, H2 = 0.f;
#pragma unroll
                for (int sp = 0; sp < 8; ++sp) { const f32x4 v = AG[sp * 64 + tid]; H = v[0] * H + v[1]; A *= v[0]; }
#pragma unroll
                for (int sp = 7; sp >= 0; --sp) { const f32x4 v = AG[sp * 64 + tid]; H2 = v[2] * H2 + v[3]; A2 *= v[2]; }
                cagg[(size_t)(b * 64 + j) * 1024 + 64 * h + tid] = (f32x4){A, H, A2, H2}; }
        } else {
            const LAS float* car = (const LAS float*)(lds + SCAR_OFF) + jl * 128;
            float cf = car[ch], cb = car[64 + ch];
            const LAS f32x2* AG2 = (const LAS f32x2*)(lds + SAGG_OFF) + 2 * ch;
#pragma unroll
            for (int sp = 0; sp < 8; ++sp) { const f32x2 v = AG2[sp * 128]; if (sp < s) cf = v[0] * cf + v[1]; }
            asm volatile("" ::: "memory");
#pragma unroll
            for (int sp = 7; sp >= 0; --sp) { const f32x2 v = AG2[sp * 128 + 1]; if (sp > s) cb = v[0] * cb + v[1]; }
            float y[16];
            { float H = cf;
#pragma unroll
              for (int k = 0; k < 16; ++k) { H = acc[k >> 2][0][k & 3] * H + acc[k >> 2][1][k & 3]; y[k] = H; }
              H = cb;
#pragma unroll
              for (int k = 15; k >= 0; --k) { H = acc[k >> 2][2][k & 3] * H + acc[k >> 2][3][k & 3]; y[k] += H; } }
            { LAS float* sy = (LAS float*)(lds + SUCF_OFF) + (64 * th + 16 * q) * 65 + ch;
#pragma unroll
              for (int k = 0; k < 16; ++k) sy[k * 65] = y[k]; }
            __syncthreads();
#pragma unroll
            for (int k = 0; k < 2; ++k) { const int id = tid + NTHR * k, tl = id >> 3; const LAS float* sy = (const LAS float*)(lds + SUCF_OFF) + tl * 65 + 8 * c8;
                float mv[8]; const LAS float* bgA = (const LAS float*)(lds + SBG_OFF) + 8 * c8; const LAS float* bgB = bgA + 64;
#pragma unroll
                for (int e2 = 0; e2 < 4; ++e2) {
                    const unsigned gw = pg[k][e2], zaw = pza[k][e2], zbw = pzb[k][e2], ybw = pyb[k][e2];
#pragma unroll
                    for (int hf = 0; hf < 2; ++hf) { const int e = 2 * e2 + hf;
                        const float gg = hf ? bfhi(gw) : bflo(gw), za = hf ? bfhi(zaw) : bflo(zaw), zb = hf ? bfhi(zbw) : bflo(zbw), yb = hf ? bfhi(ybw) : bflo(ybw);
                        const float zz = (-2.f * LOG2E * 0.7978845608028654f) * (gg + 0.044715f * gg * gg * gg);
                        const float pgl = 1.f + fminf(ex2(zz), 6.0e10f), pa = 1.f + fminf(ex2(-LOG2E * za + bgA[e]), 6.0e10f), pb = 1.f + fminf(ex2(-LOG2E * zb + bgB[e]), 6.0e10f);
                        mv[e] = (sy[e] * gg * pb + yb * pa * pgl) * rcp_(pa * pb * pgl); } }
                u32x4 w; w.x = pkbf(mv[0], mv[1]); w.y = pkbf(mv[2], mv[3]); w.z = pkbf(mv[4], mv[5]); w.w = pkbf(mv[6], mv[7]);
                *(u32x4*)(merged + (rowbase + t0 + tl) * 1024 + 64 * h + 8 * c8) = w; }
        }
    }
#undef SC_LOAD_U
#undef SC_STORE_U
}

struct Params { const float* in[17]; float* out; unsigned char* ws; int ph_lo, ph_hi, cg_seams, pad; };
enum { I_X = 0, I_GMIX, I_WIN, I_BGATE, I_CONVW, I_CONVB, I_LAM, I_WA, I_BA, I_WX, I_BX, I_SINK, I_WOUT, I_GFFN, I_WFFI, I_WFFO, I_GFIN };

__global__ void __launch_bounds__(NTHR, 2) fwd_kernel(Params P) {
    extern __shared__ __attribute__((aligned(16))) unsigned char lds_raw[];
    LAS unsigned char* lds = (LAS unsigned char*)lds_raw;
    const int tid = threadIdx.x, lane = tid & 63, wave = __builtin_amdgcn_readfirstlane(tid >> 6);
    const int G = gridDim.x, blk = blockIdx.x;
    unsigned char* ws = P.ws;
    bf16* Win_t = (bf16*)(ws + WS_WIN); bf16* Wffi_t = (bf16*)(ws + WS_WFFI); bf16* Wout_t = (bf16*)(ws + WS_WOUT); bf16* Wffo_t = (bf16*)(ws + WS_WFFO); bf16* WG = (bf16*)(ws + WS_WG);
    float* ss0 = (float*)(ws + WS_SS); float* ss1 = ss0 + M_; float* ss2 = ss1 + M_;
    f32x4* cagg = (f32x4*)(ws + WS_CAGG); bf16* VT = (bf16*)(ws + WS_VT); bf16* XB = (bf16*)(ws + WS_XB); bf16* MERGED = XB;
    bf16* PROJ = (bf16*)(ws + WS_PROJ); bf16* X1B = (bf16*)(ws + WS_X1B); bf16* HB = (bf16*)(ws + WS_H);
    const int lo = P.ph_lo, hi = P.ph_hi;
    volatile LAS unsigned* bst = (volatile LAS unsigned*)(lds + 131072 + 64);
    if (tid < 2) bst[tid] = 0u;
    __syncthreads();
    XcdBarrier bar = xcd_barrier_post((unsigned*)(ws + WS_BAR), bst);
#define IN(k) (lo <= (k) && (k) < hi)
#define SEAM(k) do { if (IN(k) && IN((k) + 1)) { if (P.cg_seams) cg::this_grid().sync(); else xcd_barrier(bar); } } while (0)

    if (IN(0)) {
        LAS float* scr = (LAS float*)(lds + wave * 16384);
        const int gw = blk * NWAVES + wave, NGW = G * NWAVES;
        constexpr int I_A = (D_ / 64) * (INW / 32), I_B = I_A, I_C = (D_ / 64) * (D_ / 32), I_D = (DFF / 64) * (D_ / 32), NITEMS = I_A + I_B + I_C + I_D;
        for (int it = gw; it < NITEMS; it += NGW) {
            int r = it;
            if (r < I_A) { transpose_item<0>(P.in[I_WIN], D_, INW, P.in[I_GMIX], Win_t, scr, r, lane); continue; } r -= I_A;
            if (r < I_B) { transpose_item<1>(P.in[I_WFFI], D_, INW, P.in[I_GFFN], Wffi_t, scr, r, lane); continue; } r -= I_B;
            if (r < I_C) { transpose_item<0>(P.in[I_WOUT], D_, D_, nullptr, Wout_t, scr, r, lane); continue; } r -= I_C;
            transpose_item<0>(P.in[I_WFFO], DFF, D_, nullptr, Wffo_t, scr, r, lane);
        }
        for (int m = gw; m < M_; m += NGW) { const f32x4* xr = (const f32x4*)(P.in[I_X] + (size_t)m * D_) + lane; f32x4 v[4]; float s = 0.f;
#pragma unroll
            for (int jx = 0; jx < 4; ++jx) { v[jx] = xr[64 * jx]; s += (v[jx][0] * v[jx][0] + v[jx][1] * v[jx][1]) + (v[jx][2] * v[jx][2] + v[jx][3] * v[jx][3]); }
            s = wave_sum(s); if (lane == 0) ss0[m] = s;
            u32x2* o8 = (u32x2*)(XB + (size_t)m * D_) + lane;
#pragma unroll
            for (int jx = 0; jx < 4; ++jx) { u32x2 w; w.x = pkbf(v[jx][0], v[jx][1]); w.y = pkbf(v[jx][2], v[jx][3]); o8[64 * jx] = w; } }
        for (int i = blk * NTHR + tid; i < 2 * M_; i += G * NTHR) ss1[i] = 0.f;
        for (int f = blk * NTHR + tid; f < 16 * 4 * 4 * 2 * 64; f += G * NTHR) { const int ln = f & 63, ks = (f >> 6) & 1, n = (f >> 7) & 3, cgx = (f >> 9) & 3, hh = f >> 11;
            const float* src = ((n & 1) ? P.in[I_WX] : P.in[I_WA]) + (size_t)(((n >> 1) * 16 + hh) * 64) * 64; const int col = 16 * cgx + (ln & 15), k0 = 32 * ks + 8 * (ln >> 4);
            u32x4 w; w.x = pkbf(src[(k0 + 0) * 64 + col], src[(k0 + 1) * 64 + col]); w.y = pkbf(src[(k0 + 2) * 64 + col], src[(k0 + 3) * 64 + col]);
            w.z = pkbf(src[(k0 + 4) * 64 + col], src[(k0 + 5) * 64 + col]); w.w = pkbf(src[(k0 + 6) * 64 + col], src[(k0 + 7) * 64 + col]);
            *(u32x4*)(WG + (size_t)f * 8) = w; }
    }
    SEAM(0);
    if (IN(1)) {
        pg8::Gemm g{XB, Win_t, M_, INW, D_}; pg8::StaticOrder S; S.init(M_, INW, G, blk);
        pg8::EpiProj E{PROJ, VT, ss0, QSCALE};
        pg8::gemm_phase<pg8::EpiProj, pg8::StaticOrder, true, true>(lds, g, S, E);
    }
    SEAM(1);
    if (IN(2)) {
        for (int u = blk; u < 1024; u += G) { const int g = u & 3, rest = u >> 2; attn_unit(lds, PROJ, VT, P.in[I_SINK], rest >> 7, g, rest & 127, tid); }
        for (int rr = blk; rr < 256; rr += G) { const int b = rr >> 7, h = (rr >> 3) & 15, run = rr & 7;
            scan_run<false>(lds, PROJ, WG, P.in[I_CONVW], P.in[I_CONVB], P.in[I_LAM], P.in[I_BA], P.in[I_BX], P.in[I_BGATE], cagg, MERGED, b, h, 8 * run, tid); }
    }
    SEAM(2);
    if (IN(3)) {
        for (int rr = blk; rr < 256; rr += G) { const int b = rr >> 7, h = (rr >> 3) & 15, run = rr & 7;
            __syncthreads();
            scan_run<true>(lds, PROJ, WG, P.in[I_CONVW], P.in[I_CONVB], P.in[I_LAM], P.in[I_BA], P.in[I_BX], P.in[I_BGATE], cagg, MERGED, b, h, 8 * run, tid); }
    }
    SEAM(3);
    if (IN(4)) {
        pg8::Gemm g{MERGED, Wout_t, M_, D_, D_}; pg8::StaticOrder S; S.init(M_, D_, G, blk);
        pg8::EpiResid E{P.in[I_X], P.out, X1B, ss1};
        pg8::gemm_phase<pg8::EpiResid, pg8::StaticOrder, true, true>(lds, g, S, E);
    }
    SEAM(4);
    if (IN(5)) {
        pg8::Gemm g{X1B, Wffi_t, M_, INW, D_}; pg8::StaticOrder S; S.init(M_, INW, G, blk);
        pg8::EpiSwiGLU E{HB, ss1};
        pg8::gemm_phase<pg8::EpiSwiGLU, pg8::StaticOrder, true, true>(lds, g, S, E);
    }
    SEAM(5);
    if (IN(6)) {
        pg8::Gemm g{HB, Wffo_t, M_, D_, DFF}; pg8::StaticOrder S; S.init(M_, D_, G, blk);
        pg8::EpiResid E{P.out, P.out, nullptr, ss2};
        pg8::gemm_phase<pg8::EpiResid, pg8::StaticOrder, true, true>(lds, g, S, E);
    }
    SEAM(6);
    if (IN(7)) {
        const int gw = blk * NWAVES + wave, NGW = G * NWAVES;
        f32x4 gf[4];
#pragma unroll
        for (int jx = 0; jx < 4; ++jx) gf[jx] = ((const f32x4*)P.in[I_GFIN])[lane + 64 * jx];
        for (int m = gw; m < M_; m += NGW) { f32x4* xr = (f32x4*)(P.out + (size_t)m * D_) + lane; const float rs = rsqrtf(ss2[m] * (1.0f / 1024.0f) + 1e-6f);
#pragma unroll
            for (int jx = 0; jx < 4; ++jx) { f32x4 v = xr[64 * jx]; xr[64 * jx] = v * rs * gf[jx]; } }
    }
#undef IN
#undef SEAM
}

extern "C" void kernel_launch(void* const* d_in, const int* in_sizes, int n_in, void* d_out, int out_size, void* d_ws, size_t ws_size, hipStream_t stream) {
    static int grid = 0;
    if (grid == 0) {
        if (n_in != 17 || out_size != M_ * D_ || ws_size < WS_END) { fprintf(stderr, "kernel_launch: unexpected problem (n_in %d, out %d, ws %zu)\n", n_in, out_size, ws_size); grid = -1; return; }
        int dev = 0, cus = 0, per_cu = 0;
        if (hipGetDevice(&dev) != hipSuccess || hipDeviceGetAttribute(&cus, hipDeviceAttributeMultiprocessorCount, dev) != hipSuccess) { grid = -1; return; }
        if (hipFuncSetAttribute((const void*)fwd_kernel, hipFuncAttributeMaxDynamicSharedMemorySize, LDS_BYTES) != hipSuccess) { fprintf(stderr, "kernel_launch: hipFuncSetAttribute failed\n"); grid = -1; return; }
        if (hipOccupancyMaxActiveBlocksPerMultiprocessor(&per_cu, (const void*)fwd_kernel, NTHR, LDS_BYTES) != hipSuccess || per_cu < 1) { fprintf(stderr, "kernel_launch: occupancy query says %d blocks/CU\n", per_cu); grid = -1; return; }
        grid = cus;
    }
    if (grid < 0) return;
    if (hipMemsetAsync((char*)d_ws + WS_BAR, 0, BAR_BYTES, stream) != hipSuccess) { fprintf(stderr, "kernel_launch: memset failed\n"); return; }
    Params p{};
    for (int i = 0; i < 17; ++i) p.in[i] = (const float*)d_in[i];
    p.out = (float*)d_out; p.ws = (unsigned char*)d_ws;
#if MK_LAUNCHES == 1
    p.ph_lo = 0; p.ph_hi = NPH; p.cg_seams = 0;
    void* args[] = {&p};
    hipError_t e = hipLaunchCooperativeKernel((const void*)fwd_kernel, dim3(grid), dim3(NTHR), args, LDS_BYTES, stream);
    if (e != hipSuccess) fprintf(stderr, "kernel_launch: cooperative launch failed: %s (grid %d)\n", hipGetErrorString(e), grid);
#else
    for (int ph = 0; ph < NPH; ++ph) { p.ph_lo = ph; p.ph_hi = ph + 1; hipLaunchKernelGGL(fwd_kernel, dim3(grid), dim3(NTHR), LDS_BYTES, stream, p); }
#endif
}
```

```cpp
#include <hip/hip_runtime.h>
#include <hip/hip_cooperative_groups.h>
#include <cstdio>
#include <cstdint>
namespace cg = cooperative_groups;
namespace pg8 {
#define PG8_LAS __attribute__((address_space(3)))
typedef unsigned short bf16_t;
typedef short bf16x8 __attribute__((ext_vector_type(8)));
typedef float f32x4 __attribute__((ext_vector_type(4)));
typedef unsigned u32x4 __attribute__((ext_vector_type(4)));
constexpr int BM = 256, BK = 64, HALF = 128, HTB = HALF * BK * 2  , STAGE_BYTES = 8 * HTB, NXCD = 8, WGM = 8;

__host__ __device__ __forceinline__ int lds_byte(int r, int c) { const int st = (r >> 4) * 2 + (c >> 5), rr = r & 15, cc = c & 31, ob = rr * 64 + cc * 2; return st * 1024 + (ob ^ (((ob >> 9) & 1) << 5)); }
__host__ __device__ __forceinline__ void stage_rc(int b, int& R, int& C) { const int st = b / 1024, sb = b % 1024, swz = sb ^ (((sb >> 9) & 1) << 5); R = (st >> 1) * 16 + swz / 64; C = (st & 1) * 32 + (swz % 64) / 2; }
__host__ __device__ __forceinline__ int perm32(int rho) { const int n = rho >> 4, i = rho & 15; return 8 * (i >> 2) + 4 * n + (i & 3); }

struct Unit { int pm, pn; };
struct Gemm { const bf16_t* A; const bf16_t* Bt; int M, N, K; };

struct StaticOrder {
    int nM, nN, nwg, G, c;
    __host__ __device__ void init(int M, int N, int G_, int c_) { nM = M / BM; nN = N / BM; nwg = nM * nN; G = G_; c = c_; }
    __host__ __device__ bool next(int i, Unit& u) const {
        const long L = (long)i * G + c; if (L >= nwg) return false;
        int wgid = (int)L; { const int q = nwg / NXCD, r = nwg % NXCD, xcd = wgid % NXCD, off = wgid / NXCD; wgid = (xcd < r ? xcd * (q + 1) : r * (q + 1) + (xcd - r) * q) + off; }
        const int nig = WGM * nN, gid = wgid / nig, fm = gid * WGM, gsz = (nM - fm) < WGM ? (nM - fm) : WGM;
        u.pm = fm + ((wgid % nig) % gsz); u.pn = (wgid % nig) / gsz; return true;
    }
    __device__ __forceinline__ void a_ready(const Unit&) const {}
    __device__ __forceinline__ void done(const Unit&) const {}
};

__device__ __forceinline__ unsigned cvt_pk_bf16(float lo, float hi) { unsigned r; asm volatile("v_cvt_pk_bf16_f32 %0, %1, %2" : "=v"(r) : "v"(lo), "v"(hi)); return r; }
typedef unsigned u32x2 __attribute__((ext_vector_type(2)));
constexpr float RMS_EPS = 1e-6f;
struct EpiProj {
    static constexpr bool PERM = true, AFTER_DRAIN = false;
    bf16_t* proj; bf16_t* vt; const float* ss; float qscale;
    __device__ __forceinline__ void operator()(const f32x4 (&acc)[2][2][4][2], const Unit& u, int wr, int wc, int fr, int fq) const {
        const int row0 = u.pm * BM + wr * 64 + fr, ct = wc * 32 + 8 * fq;
        const float sc = (u.pn >= 8 && u.pn < 12) ? qscale : 1.f;
        if (u.pn != 13) {
            bf16_t* base = proj + (size_t)u.pn * BM + ct;
#pragma unroll
            for (int ai = 0; ai < 2; ++ai)
#pragma unroll
                for (int m = 0; m < 4; ++m) { const int row = row0 + ai * HALF + m * 16; const float rs = rsqrtf(ss[row] * (1.0f / 1024.0f) + RMS_EPS) * sc;
#pragma unroll
                    for (int bj = 0; bj < 2; ++bj) { const f32x4 v0 = acc[ai][bj][m][0] * rs, v1 = acc[ai][bj][m][1] * rs;
                        u32x4 w; w.x = cvt_pk_bf16(v0[0], v0[1]); w.y = cvt_pk_bf16(v0[2], v0[3]); w.z = cvt_pk_bf16(v1[0], v1[1]); w.w = cvt_pk_bf16(v1[2], v1[3]);
                        *(u32x4*)(base + (size_t)row * 5632 + bj * HALF) = w; } }
        } else {
#pragma unroll
            for (int ai = 0; ai < 2; ++ai)
#pragma unroll
                for (int m = 0; m < 4; ++m) { const int row = row0 + ai * HALF + m * 16; const float rs = rsqrtf(ss[row] * (1.0f / 1024.0f) + RMS_EPS);
                    const int b = row >> 13, s = row & 8191;
#pragma unroll
                    for (int bj = 0; bj < 2; ++bj)
#pragma unroll
                        for (int n = 0; n < 2; ++n) { const f32x4 v = acc[ai][bj][m][n] * rs;
#pragma unroll
                            for (int e = 0; e < 4; ++e) { const int cidx = bj * HALF + ct + 4 * n + e, g = cidx >> 6, d = cidx & 63;
                                vt[(size_t)((b * 4 + g) * 64 + d) * 8192 + s] = (bf16_t)(cvt_pk_bf16(v[e], 0.f) & 0xffffu); } } }
        }
    }
};
template <int MODE> struct EpiResid {
    static constexpr bool PERM = false, AFTER_DRAIN = false;
    const float* basef; const bf16_t* baseb; float* out; bf16_t* ob; float* ss;
    __device__ __forceinline__ void operator()(const f32x4 (&acc)[2][2][4][2], const Unit& u, int wr, int wc, int fr, int fq) const {
        const int col0 = u.pn * BM + wc * 32 + 4 * fq;
#pragma unroll
        for (int ai = 0; ai < 2; ++ai)
#pragma unroll
            for (int m = 0; m < 4; ++m) { const int row = u.pm * BM + ai * HALF + wr * 64 + m * 16 + fr; const size_t off = (size_t)row * 1024 + col0; float q = 0.f;
#pragma unroll
                for (int bj = 0; bj < 2; ++bj)
#pragma unroll
                    for (int n = 0; n < 2; ++n) { const size_t o_ = off + bj * HALF + n * 16; f32x4 bs;
                        if (MODE == 0) bs = *(const f32x4*)(basef + o_);
                        else { const u32x2 w = *(const u32x2*)(baseb + o_); bs = (f32x4){__uint_as_float(w.x << 16), __uint_as_float(w.x & 0xffff0000u), __uint_as_float(w.y << 16), __uint_as_float(w.y & 0xffff0000u)}; }
                        const f32x4 o = bs + acc[ai][bj][m][n];
                        q += (o[0] * o[0] + o[1] * o[1]) + (o[2] * o[2] + o[3] * o[3]);
                        if (MODE == 0) { u32x2 w; w.x = cvt_pk_bf16(o[0], o[1]); w.y = cvt_pk_bf16(o[2], o[3]); *(u32x2*)(ob + o_) = w; }
                        else *(f32x4*)(out + o_) = o; }
                q += __shfl_xor(q, 16); q += __shfl_xor(q, 32);
                if (fq == 0) atomicAdd(ss + row, q);
                if (m & 1) asm volatile("" ::: "memory"); }
    }
};
struct EpiSwiGLU {
    static constexpr bool PERM = true, AFTER_DRAIN = false;
    bf16_t* H; const float* ss;
    __device__ __forceinline__ void operator()(const f32x4 (&acc)[2][2][4][2], const Unit& u, int wr, int wc, int fr, int fq) const {
        const int row0 = u.pm * BM + wr * 64 + fr, col = u.pn * HALF + wc * 32 + 8 * fq;
#pragma unroll
        for (int ai = 0; ai < 2; ++ai)
#pragma unroll
            for (int m = 0; m < 4; ++m) { const int row = row0 + ai * HALF + m * 16; const float rs = rsqrtf(ss[row] * (1.0f / 1024.0f) + RMS_EPS);
                float hv[8];
#pragma unroll
                for (int n = 0; n < 2; ++n) { const f32x4 g = acc[ai][0][m][n] * rs, up = acc[ai][1][m][n] * rs;
#pragma unroll
                    for (int e = 0; e < 4; ++e) { const float sg = __builtin_amdgcn_rcpf(1.f + __builtin_amdgcn_exp2f(-1.4426950408889634f * g[e])); hv[4 * n + e] = g[e] * sg * up[e]; } }
                u32x4 w; w.x = cvt_pk_bf16(hv[0], hv[1]); w.y = cvt_pk_bf16(hv[2], hv[3]); w.z = cvt_pk_bf16(hv[4], hv[5]); w.w = cvt_pk_bf16(hv[6], hv[7]);
                *(u32x4*)(H + (size_t)row * 2816 + col) = w; }
    }
};
template <class Epi, class Sched, bool ALIGN_EPI = false, bool SP2 = false>
__device__ __forceinline__ void gemm_phase(PG8_LAS unsigned char* lds, const Gemm g, const Sched& S, const Epi& E) {
    const int tid = threadIdx.x, wid = __builtin_amdgcn_readfirstlane(tid >> 6), lane = tid & 63, wr = wid >> 2, wc = wid & 3, fr = lane & 15, fq = lane >> 4;
    const int K = g.K, nt = K / BK;
    unsigned voffA[2], voffB[2];
#pragma unroll
    for (int i = 0; i < 2; ++i) { int R, C; stage_rc(tid * 16 + i * 8192, R, C); const int Rb = Epi::PERM ? ((R & ~31) + perm32(R & 31)) : R;
        voffA[i] = (unsigned)(R * K + C) * 2u; voffB[i] = (unsigned)(Rb * K + C) * 2u; }
    const size_t kstep = (size_t)(BK * 2);
    const size_t hstep = (size_t)HALF * K * 2;
    const size_t tstep = 2 * hstep;
    const unsigned ldsw = (unsigned)wid * 1024u;
    const int aoff = lds_byte(wr * 64 + fr, fq * 8), boff = lds_byte(wc * 32 + fr, fq * 8);
#define PG8_SA(b, h) (((b) * 2 + (h)) * HTB)
#define PG8_SB(b, h) ((4 + (b) * 2 + (h)) * HTB)
#define PG8_STAGE(bufoff, gbase, voff) do { _Pragma("unroll") for (int _i = 0; _i < 2; ++_i) \
        __builtin_amdgcn_global_load_lds((const unsigned*)((const char*)(gbase) + (voff)[_i]), (PG8_LAS unsigned*)(lds + (bufoff) + ldsw + _i * 8192), 16, 0, 0); } while (0)
#define PG8_LDA(dst, b, h) do { _Pragma("unroll") for (int m = 0; m < 4; ++m) _Pragma("unroll") for (int k = 0; k < 2; ++k) dst[m][k] = *(const PG8_LAS bf16x8*)(lds + PG8_SA(b, h) + aoff + m * 2048 + k * 1024); } while (0)
#define PG8_LDB(dst, b, h) do { _Pragma("unroll") for (int n = 0; n < 2; ++n) _Pragma("unroll") for (int k = 0; k < 2; ++k) dst[n][k] = *(const PG8_LAS bf16x8*)(lds + PG8_SB(b, h) + boff + n * 2048 + k * 1024); } while (0)
#define PG8_MMA(ai, bj, At, Bt) do { __builtin_amdgcn_s_setprio(1); _Pragma("unroll") for (int m = 0; m < 4; ++m) _Pragma("unroll") for (int n = 0; n < 2; ++n) _Pragma("unroll") for (int k = 0; k < 2; ++k) \
        acc[ai][bj][m][n] = __builtin_amdgcn_mfma_f32_16x16x32_bf16(Bt[n][k], At[m][k], acc[ai][bj][m][n], 0, 0, 0); __builtin_amdgcn_s_setprio(0); } while (0)
#define PG8_WAIT_V(n) asm volatile("s_waitcnt vmcnt(" #n ")" ::: "memory")
#define PG8_WAIT_L(n) asm volatile("s_waitcnt lgkmcnt(" #n ")" ::: "memory")
#define PG8_BAR __builtin_amdgcn_s_barrier()
#define PG8_SCHED __builtin_amdgcn_sched_barrier(0)
    Unit cur, nxt; int ui = 0;
    if (!S.next(0, cur)) return;
    f32x4 acc[2][2][4][2];
#pragma unroll
    for (int a = 0; a < 2; ++a)
#pragma unroll
        for (int b = 0; b < 2; ++b)
#pragma unroll
            for (int m = 0; m < 4; ++m)
#pragma unroll
                for (int n = 0; n < 2; ++n) acc[a][b][m][n] = (f32x4){0.f, 0.f, 0.f, 0.f};
    bf16x8 At[4][2], B0[2][2], B1[2][2];
    const char* cA = (const char*)g.A + (size_t)cur.pm * tstep; const char* cB = (const char*)g.Bt + (size_t)cur.pn * tstep;
    S.a_ready(cur);
    if constexpr (SP2) {
        PG8_STAGE(PG8_SB(0, 0), cB, voffB); PG8_STAGE(PG8_SB(0, 1), cB + hstep, voffB); PG8_STAGE(PG8_SA(0, 0), cA, voffA); PG8_STAGE(PG8_SA(0, 1), cA + hstep, voffA);
        if (wr == 1) PG8_BAR;
        PG8_WAIT_V(2); PG8_BAR;
        PG8_STAGE(PG8_SB(1, 0), cB + kstep, voffB); PG8_STAGE(PG8_SA(1, 0), cA + kstep, voffA); PG8_STAGE(PG8_SB(1, 1), cB + hstep + kstep, voffB);
        PG8_WAIT_V(6); PG8_BAR;
    } else {
        PG8_STAGE(PG8_SB(0, 0), cB, voffB); PG8_STAGE(PG8_SA(0, 0), cA, voffA); PG8_STAGE(PG8_SB(0, 1), cB + hstep, voffB); PG8_STAGE(PG8_SA(0, 1), cA + hstep, voffA);
        if (wr == 1) PG8_BAR;
        PG8_WAIT_V(4); PG8_BAR;
        PG8_STAGE(PG8_SB(1, 0), cB + kstep, voffB); PG8_STAGE(PG8_SA(1, 0), cA + kstep, voffA); PG8_STAGE(PG8_SB(1, 1), cB + hstep + kstep, voffB);
        PG8_WAIT_V(6); PG8_BAR;
    }
    for (;;) {
        const bool has_next = S.next(ui + 1, nxt);
        const char* nA = has_next ? (const char*)g.A + (size_t)nxt.pm * tstep : cA; const char* nB = has_next ? (const char*)g.Bt + (size_t)nxt.pn * tstep : cB;
        for (int t = 0; t < nt; t += 2) {
            const bool last = (t == nt - 2);
            const char* a1 = cA + (size_t)(t + 1) * kstep;
            const char* a2 = last ? nA : cA + (size_t)(t + 2) * kstep; const char* b2 = last ? nB : cB + (size_t)(t + 2) * kstep;
            const char* a3 = a2 + kstep; const char* b3 = b2 + kstep;
            if (last && has_next) S.a_ready(nxt);
            if constexpr (SP2) {
            PG8_LDB(B0, 0, 0); PG8_LDB(B1, 0, 1); PG8_SCHED; PG8_LDA(At, 0, 0); PG8_STAGE(PG8_SA(1, 1), a1 + hstep, voffA);
            PG8_WAIT_V(8); PG8_WAIT_L(0); PG8_BAR; PG8_MMA(0, 0, At, B0); PG8_MMA(0, 1, At, B1); PG8_BAR; PG8_SCHED;
            PG8_LDA(At, 0, 1); PG8_STAGE(PG8_SB(0, 0), b2, voffB); PG8_STAGE(PG8_SB(0, 1), b2 + hstep, voffB); PG8_STAGE(PG8_SA(0, 0), a2, voffA);
            PG8_WAIT_V(8); PG8_WAIT_L(0); PG8_BAR; PG8_MMA(1, 0, At, B0); PG8_MMA(1, 1, At, B1); PG8_BAR; PG8_SCHED;
            PG8_LDB(B0, 1, 0); PG8_LDB(B1, 1, 1); PG8_SCHED; PG8_LDA(At, 1, 0); PG8_STAGE(PG8_SA(0, 1), a2 + hstep, voffA);
            PG8_WAIT_V(8); PG8_WAIT_L(0); PG8_BAR; PG8_MMA(0, 0, At, B0); PG8_MMA(0, 1, At, B1); PG8_BAR; PG8_SCHED;
            PG8_LDA(At, 1, 1); PG8_STAGE(PG8_SB(1, 0), b3, voffB); PG8_STAGE(PG8_SB(1, 1), b3 + hstep, voffB); PG8_STAGE(PG8_SA(1, 0), a3, voffA);
            PG8_WAIT_V(8); PG8_WAIT_L(0); PG8_BAR; PG8_MMA(1, 0, At, B0); PG8_MMA(1, 1, At, B1); PG8_BAR; PG8_SCHED;
            } else {
            PG8_LDB(B0, 0, 0); PG8_SCHED; PG8_LDA(At, 0, 0); PG8_STAGE(PG8_SA(1, 1), a1 + hstep, voffA);
            PG8_WAIT_L(8); PG8_BAR; PG8_WAIT_L(0); PG8_MMA(0, 0, At, B0); PG8_BAR; PG8_SCHED;
            PG8_LDB(B1, 0, 1); PG8_STAGE(PG8_SB(0, 0), b2, voffB);
            PG8_BAR; PG8_WAIT_L(0); PG8_MMA(0, 1, At, B1); PG8_BAR;
            PG8_LDA(At, 0, 1); PG8_STAGE(PG8_SA(0, 0), a2, voffA);
            PG8_BAR; PG8_WAIT_L(0); PG8_MMA(1, 0, At, B0); PG8_BAR; PG8_SCHED;
            PG8_STAGE(PG8_SB(0, 1), b2 + hstep, voffB);
            PG8_WAIT_V(6); PG8_BAR; PG8_MMA(1, 1, At, B1); PG8_BAR;
            PG8_LDB(B0, 1, 0); PG8_SCHED; PG8_LDA(At, 1, 0); PG8_STAGE(PG8_SA(0, 1), a2 + hstep, voffA);
            PG8_WAIT_L(8); PG8_BAR; PG8_WAIT_L(0); PG8_MMA(0, 0, At, B0); PG8_BAR; PG8_SCHED;
            PG8_LDB(B1, 1, 1); PG8_STAGE(PG8_SB(1, 0), b3, voffB);
            PG8_BAR; PG8_WAIT_L(0); PG8_MMA(0, 1, At, B1); PG8_BAR;
            PG8_LDA(At, 1, 1); PG8_STAGE(PG8_SA(1, 0), a3, voffA);
            PG8_BAR; PG8_WAIT_L(0); PG8_MMA(1, 0, At, B0); PG8_BAR; PG8_SCHED;
            PG8_STAGE(PG8_SB(1, 1), b3 + hstep, voffB);
            PG8_WAIT_V(6); PG8_BAR; PG8_MMA(1, 1, At, B1); PG8_BAR;
            }
        }
        if constexpr (ALIGN_EPI) { if (wr == 0) PG8_BAR; }
        if constexpr (!Epi::AFTER_DRAIN) { E(acc, cur, wr, wc, fr, fq); S.done(cur); }
        if (!has_next) break;
#pragma unroll
        for (int a = 0; a < 2; ++a)
#pragma unroll
            for (int b = 0; b < 2; ++b)
#pragma unroll
                for (int m = 0; m < 4; ++m)
#pragma unroll
                    for (int n = 0; n < 2; ++n) acc[a][b][m][n] = (f32x4){0.f, 0.f, 0.f, 0.f};
        cur = nxt; cA = nA; cB = nB; ++ui;
        if constexpr (ALIGN_EPI) { if (wr == 1) PG8_BAR; }
    }
    PG8_WAIT_V(0);
    if constexpr (!ALIGN_EPI) { if (wr == 0) PG8_BAR; }
    PG8_BAR;
    if constexpr (Epi::AFTER_DRAIN) { E.fused(acc, cur, wr, wc, fr, fq, lds, wid, lane); S.done(cur); }
#undef PG8_SA
#undef PG8_SB
#undef PG8_STAGE
#undef PG8_LDA
#undef PG8_LDB
#undef PG8_MMA
#undef PG8_WAIT_V
#undef PG8_WAIT_L
#undef PG8_BAR
#undef PG8_SCHED
}
}
#ifndef MK_LAUNCHES
#define MK_LAUNCHES 1
#endif
#define LAS __attribute__((address_space(3)))
typedef unsigned short bf16;
typedef unsigned u32x4 __attribute__((ext_vector_type(4)));
typedef unsigned u32x2 __attribute__((ext_vector_type(2)));
typedef float f32x4 __attribute__((ext_vector_type(4)));
typedef float f32x2 __attribute__((ext_vector_type(2)));
typedef float f32x16 __attribute__((ext_vector_type(16)));
typedef short bf16x8 __attribute__((ext_vector_type(8)));
typedef __bf16 bf16x2_t __attribute__((ext_vector_type(2)));

constexpr int NWAVES = 8, NTHR = 512, NPH = 8;
constexpr int B_ = 2, S_ = 8192, D_ = 1024, M_ = B_ * S_, INW = 5632, DFF = 2816;
constexpr float LOG2E = 1.4426950408889634f;
constexpr float QSCALE = 0.125f * LOG2E;
constexpr size_t MiB = 1u << 20;
constexpr size_t WS_WIN = 0, WS_WFFI = 11 * MiB, WS_WOUT = 22 * MiB, WS_WFFO = 24 * MiB, WS_WG = 30 * MiB, WS_SS = 31 * MiB, WS_CAGG = 32 * MiB, WS_VT = 34 * MiB,
                 WS_XB = 42 * MiB  , WS_PROJ = 74 * MiB  , WS_X1B = WS_PROJ  , WS_H = 106 * MiB  , WS_END = 250 * MiB;
constexpr size_t WS_BAR = 31 * MiB + 512 * 1024, BAR_BYTES = 16384;
constexpr int LDS_BYTES = 131072 + 1024;

__device__ __forceinline__ float bflo(unsigned w) { return __uint_as_float(w << 16); }
__device__ __forceinline__ float bfhi(unsigned w) { return __uint_as_float(w & 0xffff0000u); }
__device__ __forceinline__ unsigned pkbf(float lo, float hi) { f32x2 v = {lo, hi}; bf16x2_t b = __builtin_convertvector(v, bf16x2_t); return __builtin_bit_cast(unsigned, b); }
__device__ __forceinline__ float ex2(float x) { return __builtin_amdgcn_exp2f(x); }
__device__ __forceinline__ float rcp_(float x) { return __builtin_amdgcn_rcpf(x); }
__device__ __forceinline__ float sigm(float x) { return rcp_(1.f + ex2(-LOG2E * x)); }
__device__ __forceinline__ float wave_sum(float v) {
#pragma unroll
    for (int o = 1; o < 64; o <<= 1) v += __shfl_xor(v, o);
    return v;
}

#define XB_TMO      128
#define XB_XCNT(j)  (256  + 64 * (j))
#define XB_XSUB(j)  (1280 + 64 * (j))
#define XB_XGEN(j)  (2304 + 64 * (j))
#define XB_TOP      3328
#define XB_TOPGEN   3392
#define XCD_BAR_WORDS 3456
#define XB_SPIN_CAP (1u << 18)

__device__ __forceinline__ unsigned xb_ld(unsigned* p)              { return __hip_atomic_load(p, __ATOMIC_RELAXED, __HIP_MEMORY_SCOPE_AGENT); }
__device__ __forceinline__ unsigned xb_add(unsigned* p, unsigned v) { return __hip_atomic_fetch_add(p, v, __ATOMIC_RELAXED, __HIP_MEMORY_SCOPE_AGENT); }
__device__ __forceinline__ unsigned xb_xcc_id() { return (unsigned)__builtin_amdgcn_s_getreg((3 << 11) | 20) & 0xFu; }
#define XB_SPIN(cond, bar) do { unsigned _sp = 0; while (cond) { __builtin_amdgcn_s_sleep(1); \
    if ((++_sp & 255u) == 0u) { if (xb_ld(&(bar)[XB_TMO])) break; if (_sp > XB_SPIN_CAP) { atomicAdd(&(bar)[XB_TMO], 1u); break; } } } } while (0)

struct XcdBarrier {
    unsigned* bar; unsigned x;
    volatile LAS unsigned* st;
};

__device__ __forceinline__ XcdBarrier xcd_barrier_post(unsigned* bar, volatile LAS unsigned* st) {
    XcdBarrier b; b.bar = bar; b.x = xb_xcc_id(); b.st = st;
    if (threadIdx.x == 0) (void)xb_add(&bar[XB_XCNT(b.x)], 1u);
    return b;
}
__device__ __forceinline__ void xcd_barrier_complete(unsigned* bar, unsigned x, unsigned& nloc, unsigned& nx) {
    const unsigned G = gridDim.x * gridDim.y * gridDim.z;
    unsigned sum, cnt, mine, sp = 0u;
    for (;;) {
        sum = 0u; cnt = 0u; mine = 0u;
#pragma unroll
        for (unsigned j = 0; j < 16; ++j) { const unsigned c = xb_ld(&bar[XB_XCNT(j)]); sum += c; cnt += (c > 0u) ? 1u : 0u; mine = (j == x) ? c : mine; }
        if (sum == G) break;
        __builtin_amdgcn_s_sleep(1);
        if ((++sp & 255u) == 0u) { if (xb_ld(&bar[XB_TMO])) break; if (sp > XB_SPIN_CAP) { atomicAdd(&bar[XB_TMO], 1u); break; } }
    }
    nloc = mine > 0u ? mine : 1u; nx = cnt > 0u ? cnt : 1u;
}

__device__ __forceinline__ void xcd_barrier(const XcdBarrier& b) {
    asm volatile("s_waitcnt vmcnt(0)" ::: "memory");
    __syncthreads();
    if (threadIdx.x == 0) {
        unsigned* bar = b.bar;
        __builtin_amdgcn_s_waitcnt(0);
        unsigned nloc = b.st[0], nx = b.st[1];
        if (nloc == 0u) { xcd_barrier_complete(bar, b.x, nloc, nx); b.st[0] = nloc; b.st[1] = nx; }
        const unsigned old = xb_add(&bar[XB_XSUB(b.x)], 1u);
        const unsigned gen = old / nloc;
        if (old + 1u == (gen + 1u) * nloc) {
            __builtin_amdgcn_fence(__ATOMIC_RELEASE, "agent");
            asm volatile("s_waitcnt vmcnt(0)" ::: "memory");
            const unsigned og = xb_add(&bar[XB_TOP], 1u);
            const unsigned tg = og / nx;
            if (og + 1u == (tg + 1u) * nx) xb_add(&bar[XB_TOPGEN], 1u);
            else XB_SPIN(xb_ld(&bar[XB_TOPGEN]) == tg, bar);
            __builtin_amdgcn_fence(__ATOMIC_ACQUIRE, "agent");
            xb_add(&bar[XB_XGEN(b.x)], 1u);
            asm volatile("s_waitcnt vmcnt(0)" ::: "memory");
        } else {
            XB_SPIN(xb_ld(&bar[XB_XGEN(b.x)]) == gen, bar);
            __builtin_amdgcn_fence(__ATOMIC_ACQUIRE, "agent");
            asm volatile("s_waitcnt vmcnt(0)" ::: "memory");
        }
    }
    __syncthreads();
}

template <int MODE>
__device__ __forceinline__ void transpose_item(const float* W, int K, int N, const float* gk, bf16* WT, LAS float* scr, int item, int lane) {
    const int nblk = N / 32, kb = item / nblk, nb = item % nblk, k0 = 64 * kb, n0 = 32 * nb;
    { f32x4 v[8]; const int kr = lane >> 3, c4 = lane & 7;
#pragma unroll
      for (int i = 0; i < 8; ++i) v[i] = *(const f32x4*)(W + (size_t)(k0 + 8 * i + kr) * N + n0 + 4 * c4);
#pragma unroll
      for (int i = 0; i < 8; ++i) { const int kk = 8 * i + kr; f32x4 w = v[i]; if (gk) w = w * gk[k0 + kk];
          LAS float* d = scr + kk * 33 + 4 * c4; d[0] = w[0]; d[1] = w[1]; d[2] = w[2]; d[3] = w[3]; } }
    asm volatile("s_waitcnt lgkmcnt(0)" ::: "memory");
    const int c = lane & 7;
#pragma unroll
    for (int j = 0; j < 4; ++j) { const int n = (lane >> 3) + 8 * j; const LAS float* s = scr + (8 * c) * 33 + n;
        u32x4 o; o.x = pkbf(s[0 * 33], s[1 * 33]); o.y = pkbf(s[2 * 33], s[3 * 33]); o.z = pkbf(s[4 * 33], s[5 * 33]); o.w = pkbf(s[6 * 33], s[7 * 33]);
        const int nn = n0 + n; int drow = nn;
        if (MODE == 1) drow = (nn < DFF) ? ((nn >> 7) * 256 + (nn & 127)) : (((nn - DFF) >> 7) * 256 + 128 + ((nn - DFF) & 127));
        *(u32x4*)(WT + (size_t)drow * K + k0 + 8 * c) = o; }
    asm volatile("s_waitcnt lgkmcnt(0)" ::: "memory");
}

constexpr int KS_OFF = 0, KS_PITCH = 144, VTS_OFF = 320 * KS_PITCH, VTS_PITCH = 656;
__device__ __forceinline__ int crow(int r, int hi) { return (r & 3) + 8 * (r >> 2) + 4 * hi; }
template <int MODE>
__device__ __forceinline__ void attn_tile(LAS unsigned char* lds, int kt, int j, int kb, int r32, int hi, const bf16x8 (&qf)[4], const f32x16& skp, float slope2, float r32f,
                                          float& m, float& l, f32x16& o0, f32x16& o1) {
    f32x16 p;
    if (MODE == 0) {
#pragma unroll
        for (int i = 0; i < 16; ++i) p[i] = 0.f;
    } else if (MODE == 1) p = skp;
    else {
#pragma unroll
        for (int i = 0; i < 16; ++i) p[i] = -skp[i];
    }
#pragma unroll
    for (int ds = 0; ds < 4; ++ds) { const bf16x8 kf = *(const LAS bf16x8*)(lds + KS_OFF + (kt + r32) * KS_PITCH + 32 * ds + 16 * hi);
        p = __builtin_amdgcn_mfma_f32_32x32x16_bf16(kf, qf[ds], p, 0, 0, 0); }
    float mx = -1e30f, off;
    if (MODE == 0) {
        int rv = r32, hv = hi; asm volatile("" : "+v"(rv), "+v"(hv));
#pragma unroll
        for (int i = 0; i < 16; ++i) { const int kk = crow(i, hv), dist = rv + 128 - 32 * j - kk, sa = kb + kt + kk;
            const bool valid = (dist <= 128) && (dist >= -128) && (sa >= 0) && (sa < S_);
            const float sc = valid ? (p[i] - slope2 * fabsf((float)dist)) : -1e30f; p[i] = sc; mx = fmaxf(mx, sc); }
        mx = fmaxf(mx, __shfl_xor(mx, 32));
        off = 0.f;
    } else {
#pragma unroll
        for (int i = 0; i < 16; ++i) mx = fmaxf(mx, p[i]);
        mx = fmaxf(mx, __shfl_xor(mx, 32));
        const float cj = slope2 * (float)(128 - 32 * j);
        const float base = (MODE == 1) ? -(cj + r32f) : (cj + r32f);
        mx += base; off = base;
    }
    const float mnew = fmaxf(m, mx), alpha = ex2(m - mnew), sub = mnew - off;
    float rs = 0.f;
#pragma unroll
    for (int i = 0; i < 16; ++i) { p[i] = ex2(p[i] - sub); rs += p[i]; }
    l = l * alpha + rs;
    if (__builtin_amdgcn_ballot_w64(mnew > m) != 0ull) {
#pragma unroll
        for (int i = 0; i < 16; ++i) { o0[i] *= alpha; o1[i] *= alpha; }
    }
    m = mnew;
    u32x4 w0, w1;
    w0.x = pkbf(p[0], p[1]); w0.y = pkbf(p[2], p[3]); w0.z = pkbf(p[4], p[5]); w0.w = pkbf(p[6], p[7]);
    w1.x = pkbf(p[8], p[9]); w1.y = pkbf(p[10], p[11]); w1.z = pkbf(p[12], p[13]); w1.w = pkbf(p[14], p[15]);
    const bf16x8 pb0 = __builtin_bit_cast(bf16x8, w0), pb1 = __builtin_bit_cast(bf16x8, w1);
#pragma unroll
    for (int s = 0; s < 2; ++s) {
        const LAS unsigned char* vp = lds + VTS_OFF + r32 * VTS_PITCH + 2 * (kt + 16 * s + 4 * hi);
        const u32x2 a0 = *(const LAS u32x2*)(vp), a1 = *(const LAS u32x2*)(vp + 16);
        const u32x2 c0 = *(const LAS u32x2*)(vp + 32 * VTS_PITCH), c1 = *(const LAS u32x2*)(vp + 32 * VTS_PITCH + 16);
        const u32x4 va = {a0.x, a0.y, a1.x, a1.y}, vc = {c0.x, c0.y, c1.x, c1.y};
        o0 = __builtin_amdgcn_mfma_f32_32x32x16_bf16(__builtin_bit_cast(bf16x8, va), s == 0 ? pb0 : pb1, o0, 0, 0, 0);
        o1 = __builtin_amdgcn_mfma_f32_32x32x16_bf16(__builtin_bit_cast(bf16x8, vc), s == 0 ? pb0 : pb1, o1, 0, 0, 0);
    }
}
__device__ __forceinline__ void attn_phase(LAS unsigned char* lds, bf16* proj, const bf16* vt, const float* sink, int blk, int G, int tid) {
    const int lane = tid & 63, wave = __builtin_amdgcn_readfirstlane(tid >> 6), r32 = lane & 31, hi = lane >> 5, qh = wave & 1;
    u32x4 pk[5], pv[5]; bf16x8 qn[4];
#define AT_LOAD(u_) do { const int g_ = (u_) & 3, rest_ = (u_) >> 2, qb_ = rest_ & 127, b_ = rest_ >> 7, kb_ = 64 * qb_ - 128; const size_t rb_ = (size_t)b_ * S_; \
        int tv_ = tid; asm volatile("" : "+v"(tv_)); \
        _Pragma("unroll") for (int k_ = 0; k_ < 5; ++k_) { const int id_ = tv_ + NTHR * k_; const int kr_ = id_ >> 3, c_ = id_ & 7, s_ = kb_ + kr_; pk[k_] = (u32x4){0u, 0u, 0u, 0u}; \
            if (s_ >= 0 && s_ < S_) pk[k_] = *(const u32x4*)(proj + (rb_ + s_) * INW + 3072 + 64 * g_ + 8 * c_); \
            const int d_ = id_ / 40, c2_ = id_ - 40 * d_, s2_ = kb_ + 8 * c2_; pv[k_] = (u32x4){0u, 0u, 0u, 0u}; \
            if (s2_ >= 0 && s2_ < S_) pv[k_] = *(const u32x4*)(vt + (size_t)((b_ * 4 + g_) * 64 + d_) * S_ + s2_); } \
        const bf16* qp_ = proj + (rb_ + 64 * qb_ + 32 * qh + r32) * INW + 2048 + 64 * (4 * g_ + (wave >> 1)); \
        _Pragma("unroll") for (int ds_ = 0; ds_ < 4; ++ds_) qn[ds_] = *(const bf16x8*)(qp_ + 16 * ds_ + 8 * hi); } while (0)
    if (blk < 1024) AT_LOAD(blk);
    for (int u = blk; u < 1024; u += G) {
        const int g = u & 3, rest = u >> 2, qb = rest & 127, b = rest >> 7, q0 = 64 * qb, kb = q0 - 128; const size_t rowbase = (size_t)b * S_;
        int tv = tid; asm volatile("" : "+v"(tv));
#pragma unroll
        for (int k = 0; k < 5; ++k) { const int id = tv + NTHR * k; *(LAS u32x4*)(lds + KS_OFF + (id >> 3) * KS_PITCH + (id & 7) * 16) = pk[k];
            const int d = id / 40, c2 = id - 40 * d; *(LAS u32x4*)(lds + VTS_OFF + d * VTS_PITCH + c2 * 16) = pv[k]; }
        bf16x8 qf[4];
#pragma unroll
        for (int ds = 0; ds < 4; ++ds) qf[ds] = qn[ds];
        if (u + G < 1024) AT_LOAD(u + G);
        const int hh = 4 * g + (wave >> 1), t = q0 + 32 * qh + r32;
        bf16* qp = proj + (rowbase + t) * INW + 2048 + 64 * hh;
        const float slope2 = exp2f(-0.5f * (float)(hh + 1)) * LOG2E, sink2 = sink[hh] * LOG2E, r32f = slope2 * (float)r32;
        f32x16 skp;
#pragma unroll
        for (int i = 0; i < 16; ++i) skp[i] = slope2 * (float)crow(i, hi);
        __syncthreads();
        float m = sink2, l = (hi == 0) ? 1.f : 0.f;
        f32x16 o0, o1;
#pragma unroll
        for (int i = 0; i < 16; ++i) { o0[i] = 0.f; o1[i] = 0.f; }
        const bool interior = (kb >= 0) && (kb + 320 <= S_);
        for (int j = 0; j < 9; ++j) {
            const int kt = 32 * qh + 32 * j;
            if (interior && j >= 1 && j <= 3) attn_tile<1>(lds, kt, j, kb, r32, hi, qf, skp, slope2, r32f, m, l, o0, o1);
            else if (interior && j >= 5 && j <= 7) attn_tile<2>(lds, kt, j, kb, r32, hi, qf, skp, slope2, r32f, m, l, o0, o1);
            else attn_tile<0>(lds, kt, j, kb, r32, hi, qf, skp, slope2, r32f, m, l, o0, o1);
        }
        l += __shfl_xor(l, 32);
        const float inv = 1.f / l;
#pragma unroll
        for (int g4 = 0; g4 < 4; ++g4) {
            u32x2 w; w.x = pkbf(o0[4 * g4] * inv, o0[4 * g4 + 1] * inv); w.y = pkbf(o0[4 * g4 + 2] * inv, o0[4 * g4 + 3] * inv);
            *(u32x2*)(qp + 8 * g4 + 4 * hi) = w;
            u32x2 w2; w2.x = pkbf(o1[4 * g4] * inv, o1[4 * g4 + 1] * inv); w2.y = pkbf(o1[4 * g4 + 2] * inv, o1[4 * g4 + 3] * inv);
            *(u32x2*)(qp + 32 + 8 * g4 + 4 * hi) = w2;
        }
        __syncthreads();
    }
#undef AT_LOAD
}

constexpr int SU_OFF = 0, SUCB_OFF = 16896, SUCB_PITCH = 144, SUCF_OFF = 35328, SAGG_OFF = 68608, SCAR_OFF = 76800, SBG_OFF = 80896, SCW_OFF = 81408, SWG_OFF = 82688;
template <bool PASS2>
__device__ __forceinline__ void scan_run(LAS unsigned char* lds, const bf16* proj, const bf16* wg, const float* conv_w, const float* conv_b, const float* lam, const float* lba, const float* lbx,
                                         const float* b_gate, f32x4* cagg, bf16* merged, int b, int h, int j0, int tid) {
    const int lane = tid & 63, wave = __builtin_amdgcn_readfirstlane(tid >> 6), cg_ = wave & 3, th = wave >> 2, c16 = lane & 15, q = lane >> 4;
    const size_t rowbase = (size_t)b * S_;
    u32x4 pu[3];
#define SC_LOAD_U(jj) do { _Pragma("unroll") for (int k_ = 0; k_ < 3; ++k_) { const int id_ = tid + NTHR * k_; pu[k_] = (u32x4){0u, 0u, 0u, 0u}; \
        if (id_ < 131 * 8) { const int rr_ = id_ >> 3, c_ = id_ & 7, t_ = (jj) * 128 - 2 + rr_; if (t_ >= 0 && t_ < S_) pu[k_] = *(const u32x4*)(proj + (rowbase + t_) * INW + 64 * h + 8 * c_); } } } while (0)
#define SC_STORE_U() do { _Pragma("unroll") for (int k_ = 0; k_ < 3; ++k_) { const int id_ = tid + NTHR * k_; if (id_ < 131 * 8) *(LAS u32x4*)(lds + SU_OFF + (id_ >> 3) * 128 + (id_ & 7) * 16) = pu[k_]; } } while (0)
    SC_LOAD_U(j0);
#pragma unroll
    for (int k = 0; k < 4; ++k) { const int id = tid + NTHR * k; *(LAS u32x4*)(lds + SWG_OFF + id * 16) = *(const u32x4*)(wg + (size_t)h * 16384 + id * 8); }
    const int ch = 16 * cg_ + c16, gch = 64 * h + ch;
    float ba_[2], bx_[2], sp8[2];
#pragma unroll
    for (int d = 0; d < 2; ++d) { ba_[d] = -LOG2E * lba[d * 1024 + gch]; bx_[d] = -LOG2E * lbx[d * 1024 + gch]; const float z = -lam[d * 1024 + gch]; sp8[d] = 8.f * (fmaxf(z, 0.f) + log1pf(expf(-fabsf(z)))); }
    const int cp = tid & 31, tg = tid >> 5;
    const int c8 = tid & 7;
    if (tid < 64) { LAS float* cw = (LAS float*)(lds + SCW_OFF);
#pragma unroll
        for (int k = 0; k < 4; ++k) cw[k * 64 + tid] = conv_w[k * 1024 + 64 * h + tid];
        cw[4 * 64 + tid] = conv_b[64 * h + tid];
        if (PASS2) { LAS float* bg = (LAS float*)(lds + SBG_OFF); bg[tid] = -LOG2E * b_gate[64 * h + tid]; bg[64 + tid] = -LOG2E * b_gate[1024 + 64 * h + tid]; } }
    if (PASS2) {
        if (wave == 0) { float H = 0.f; LAS float* car = (LAS float*)(lds + SCAR_OFF);
#pragma unroll 8
            for (int jj = 0; jj < j0 + 8; ++jj) { if (jj >= j0) car[(jj - j0) * 128 + lane] = H; const f32x4 v = cagg[(size_t)(b * 64 + jj) * 1024 + 64 * h + lane]; H = v[0] * H + v[1]; } }
        if (wave == 1) { float H = 0.f; LAS float* car = (LAS float*)(lds + SCAR_OFF);
#pragma unroll 8
            for (int jj = 63; jj >= j0; --jj) { if (jj < j0 + 8) car[(jj - j0) * 128 + 64 + lane] = H; const f32x4 v = cagg[(size_t)(b * 64 + jj) * 1024 + 64 * h + lane]; H = v[2] * H + v[3]; } }
    }
    for (int jl = 0; jl < 8; ++jl) {
        const int j = j0 + jl, t0 = j * 128;
        SC_STORE_U();
        if (jl < 7) SC_LOAD_U(j + 1);
        u32x4 pg[2], pza[2], pzb[2], pyb[2];
        if (PASS2) {
#pragma unroll
            for (int k = 0; k < 2; ++k) { const int id = tid + NTHR * k, tl = id >> 3; const bf16* rp = proj + (rowbase + t0 + tl) * INW + 64 * h + 8 * c8;
                pg[k] = *(const u32x4*)(rp + 1024); pyb[k] = *(const u32x4*)(rp + 2048); pza[k] = *(const u32x4*)(rp + 3584); pzb[k] = *(const u32x4*)(rp + 4608); }
        }
        __syncthreads();
        { float u0[11], u1[11], w0[4], w1[4]; const LAS float* cw = (const LAS float*)(lds + SCW_OFF) + 2 * cp;
#pragma unroll
          for (int k = 0; k < 4; ++k) { w0[k] = cw[k * 64]; w1[k] = cw[k * 64 + 1]; }
          const float bb0 = cw[4 * 64], bb1 = cw[4 * 64 + 1];
#pragma unroll
          for (int r = 0; r < 11; ++r) { const unsigned w_ = *(const LAS unsigned*)(lds + SU_OFF + (8 * tg + r) * 128 + 4 * cp); u0[r] = bflo(w_); u1[r] = bfhi(w_); }
#pragma unroll
          for (int tt = 0; tt < 8; ++tt) { const float o0 = bb0 + w0[0] * u0[tt] + w0[1] * u0[tt + 1] + w0[2] * u0[tt + 2] + w0[3] * u0[tt + 3];
              const float o1 = bb1 + w1[0] * u1[tt] + w1[1] * u1[tt + 1] + w1[2] * u1[tt + 2] + w1[3] * u1[tt + 3]; const int tl = 8 * tg + tt;
              *(LAS unsigned*)(lds + SUCB_OFF + tl * SUCB_PITCH + 4 * cp) = pkbf(o0, o1);
              LAS float* f = (LAS float*)(lds + SUCF_OFF) + tl * 65 + 2 * cp; f[0] = o0; f[1] = o1; } }
        __syncthreads();
        f32x4 acc[4][4];
#pragma unroll
        for (int mt = 0; mt < 4; ++mt)
#pragma unroll
            for (int n = 0; n < 4; ++n) acc[mt][n] = (f32x4){0.f, 0.f, 0.f, 0.f};
#pragma unroll
        for (int ks = 0; ks < 2; ++ks) { bf16x8 af[4];
#pragma unroll
            for (int mt = 0; mt < 4; ++mt) { const int trow = 64 * th + 16 * (c16 >> 2) + 4 * mt + (c16 & 3); af[mt] = *(const LAS bf16x8*)(lds + SUCB_OFF + trow * SUCB_PITCH + (32 * ks + 8 * q) * 2); }
#pragma unroll
            for (int n = 0; n < 4; ++n) { const bf16x8 bfr = *(const LAS bf16x8*)(lds + SWG_OFF + (((cg_ * 4 + n) * 2 + ks) * 64 + lane) * 16);
#pragma unroll
                for (int mt = 0; mt < 4; ++mt) acc[mt][n] = __builtin_amdgcn_mfma_f32_16x16x32_bf16(af[mt], bfr, acc[mt][n], 0, 0, 0); } }
        { const LAS float* ucf = (const LAS float*)(lds + SUCF_OFF) + (64 * th + 16 * q) * 65 + ch;
#pragma unroll
          for (int mt = 0; mt < 4; ++mt)
#pragma unroll
              for (int i = 0; i < 4; ++i) { const float uc = ucf[(4 * mt + i) * 65];
#pragma unroll
                  for (int d = 0; d < 2; ++d) { const float e1 = ex2(-LOG2E * acc[mt][2 * d][i] + ba_[d]), e2 = ex2(-LOG2E * acc[mt][2 * d + 1][i] + bx_[d]);
                      const float r = rcp_(1.f + e1), la = -r * sp8[d], a = ex2(la * LOG2E), x2 = 2.f * la, p2 = 1.f + e2;
                      const float em = (x2 > -0.1f) ? (-x2 * (1.f + x2 * (0.5f + x2 * (0.16666667f + x2 * 0.041666668f)))) : (1.f - a * a);
                      const float bi = em * __builtin_amdgcn_rsqf(fmaxf(em * p2 * p2, 1e-37f));
                      acc[mt][2 * d][i] = a; acc[mt][2 * d + 1][i] = bi * uc; } } }
        float Af = 1.f, Hf = 0.f, Ab = 1.f, Hb = 0.f;
#pragma unroll
        for (int k = 0; k < 16; ++k) { const float a = acc[k >> 2][0][k & 3]; Hf = a * Hf + acc[k >> 2][1][k & 3]; Af *= a; }
#pragma unroll
        for (int k = 15; k >= 0; --k) { const float a = acc[k >> 2][2][k & 3]; Hb = a * Hb + acc[k >> 2][3][k & 3]; Ab *= a; }
        const int s = 4 * th + q;
        LAS f32x4* AG = (LAS f32x4*)(lds + SAGG_OFF);
        AG[s * 64 + ch] = (f32x4){Af, Hf, Ab, Hb};
        __syncthreads();
        if (!PASS2) {
            if (tid < 64) { float A = 1.f, H = 0.f, A2 = 1.f, H2 = 0.f;
#pragma unroll
                for (int sp = 0; sp < 8; ++sp) { const f32x4 v = AG[sp * 64 + tid]; H = v[0] * H + v[1]; A *= v[0]; }
#pragma unroll
                for (int sp = 7; sp >= 0; --sp) { const f32x4 v = AG[sp * 64 + tid]; H2 = v[2] * H2 + v[3]; A2 *= v[2]; }
                cagg[(size_t)(b * 64 + j) * 1024 + 64 * h + tid] = (f32x4){A, H, A2, H2}; }
        } else {
            const LAS float* car = (const LAS float*)(lds + SCAR_OFF) + jl * 128;
            float cf = car[ch], cb = car[64 + ch];
            const LAS f32x2* AG2 = (const LAS f32x2*)(lds + SAGG_OFF) + 2 * ch;
#pragma unroll
            for (int sp = 0; sp < 8; ++sp) { const f32x2 v = AG2[sp * 128]; if (sp < s) cf = v[0] * cf + v[1]; }
            asm volatile("" ::: "memory");
#pragma unroll
            for (int sp = 7; sp >= 0; --sp) { const f32x2 v = AG2[sp * 128 + 1]; if (sp > s) cb = v[0] * cb + v[1]; }
            float y[16];
            { float H = cf;
#pragma unroll
              for (int k = 0; k < 16; ++k) { H = acc[k >> 2][0][k & 3] * H + acc[k >> 2][1][k & 3]; y[k] = H; }
              H = cb;
#pragma unroll
              for (int k = 15; k >= 0; --k) { H = acc[k >> 2][2][k & 3] * H + acc[k >> 2][3][k & 3]; y[k] += H; } }
            { LAS float* sy = (LAS float*)(lds + SUCF_OFF) + (64 * th + 16 * q) * 65 + ch;
#pragma unroll
              for (int k = 0; k < 16; ++k) sy[k * 65] = y[k]; }
            __syncthreads();
#pragma unroll
            for (int k = 0; k < 2; ++k) { const int id = tid + NTHR * k, tl = id >> 3; const LAS float* sy = (const LAS float*)(lds + SUCF_OFF) + tl * 65 + 8 * c8;
                float mv[8]; const LAS float* bgA = (const LAS float*)(lds + SBG_OFF) + 8 * c8; const LAS float* bgB = bgA + 64;
#pragma unroll
                for (int e2 = 0; e2 < 4; ++e2) {
                    const unsigned gw = pg[k][e2], zaw = pza[k][e2], zbw = pzb[k][e2], ybw = pyb[k][e2];
#pragma unroll
                    for (int hf = 0; hf < 2; ++hf) { const int e = 2 * e2 + hf;
                        const float gg = hf ? bfhi(gw) : bflo(gw), za = hf ? bfhi(zaw) : bflo(zaw), zb = hf ? bfhi(zbw) : bflo(zbw), yb = hf ? bfhi(ybw) : bflo(ybw);
                        const float zz = (-2.f * LOG2E * 0.7978845608028654f) * (gg + 0.044715f * gg * gg * gg);
                        const float pgl = 1.f + fminf(ex2(zz), 6.0e10f), pa = 1.f + fminf(ex2(-LOG2E * za + bgA[e]), 6.0e10f), pb = 1.f + fminf(ex2(-LOG2E * zb + bgB[e]), 6.0e10f);
                        mv[e] = (sy[e] * gg * pb + yb * pa * pgl) * rcp_(pa * pb * pgl); } }
                u32x4 w; w.x = pkbf(mv[0], mv[1]); w.y = pkbf(mv[2], mv[3]); w.z = pkbf(mv[4], mv[5]); w.w = pkbf(mv[6], mv[7]);
                *(u32x4*)(merged + (rowbase + t0 + tl) * 1024 + 64 * h + 8 * c8) = w; }
        }
    }
#undef SC_LOAD_U
#undef SC_STORE_U
}

struct Params { const float* in[17]; float* out; unsigned char* ws; int ph_lo, ph_hi, cg_seams, pad; };
enum { I_X = 0, I_GMIX, I_WIN, I_BGATE, I_CONVW, I_CONVB, I_LAM, I_WA, I_BA, I_WX, I_BX, I_SINK, I_WOUT, I_GFFN, I_WFFI, I_WFFO, I_GFIN };

__global__ void __launch_bounds__(NTHR, 2) fwd_kernel(Params P) {
    extern __shared__ __attribute__((aligned(16))) unsigned char lds_raw[];
    LAS unsigned char* lds = (LAS unsigned char*)lds_raw;
    const int tid = threadIdx.x, lane = tid & 63, wave = __builtin_amdgcn_readfirstlane(tid >> 6);
    const int G = gridDim.x, blk = blockIdx.x;
    unsigned char* ws = P.ws;
    bf16* Win_t = (bf16*)(ws + WS_WIN); bf16* Wffi_t = (bf16*)(ws + WS_WFFI); bf16* Wout_t = (bf16*)(ws + WS_WOUT); bf16* Wffo_t = (bf16*)(ws + WS_WFFO); bf16* WG = (bf16*)(ws + WS_WG);
    float* ss0 = (float*)(ws + WS_SS); float* ss1 = ss0 + M_; float* ss2 = ss1 + M_;
    f32x4* cagg = (f32x4*)(ws + WS_CAGG); bf16* VT = (bf16*)(ws + WS_VT); bf16* XB = (bf16*)(ws + WS_XB); bf16* MERGED = XB;
    bf16* PROJ = (bf16*)(ws + WS_PROJ); bf16* X1B = (bf16*)(ws + WS_X1B); bf16* HB = (bf16*)(ws + WS_H);
    const int lo = P.ph_lo, hi = P.ph_hi;
    volatile LAS unsigned* bst = (volatile LAS unsigned*)(lds + 131072 + 64);
    if (tid < 2) bst[tid] = 0u;
    __syncthreads();
    XcdBarrier bar = xcd_barrier_post((unsigned*)(ws + WS_BAR), bst);
#define IN(k) (lo <= (k) && (k) < hi)
#define SEAM(k) do { if (IN(k) && IN((k) + 1)) { if (P.cg_seams) cg::this_grid().sync(); else xcd_barrier(bar); } } while (0)

    if (IN(0)) {
        LAS float* scr = (LAS float*)(lds + wave * 16384);
        const int gw = blk * NWAVES + wave, NGW = G * NWAVES;
        constexpr int I_A = (D_ / 64) * (INW / 32), I_B = I_A, I_C = (D_ / 64) * (D_ / 32), I_D = (DFF / 64) * (D_ / 32), NITEMS = I_A + I_B + I_C + I_D;
        for (int it = gw; it < NITEMS; it += NGW) {
            int r = it;
            if (r < I_A) { transpose_item<0>(P.in[I_WIN], D_, INW, P.in[I_GMIX], Win_t, scr, r, lane); continue; } r -= I_A;
            if (r < I_B) { transpose_item<1>(P.in[I_WFFI], D_, INW, P.in[I_GFFN], Wffi_t, scr, r, lane); continue; } r -= I_B;
            if (r < I_C) { transpose_item<0>(P.in[I_WOUT], D_, D_, nullptr, Wout_t, scr, r, lane); continue; } r -= I_C;
            transpose_item<0>(P.in[I_WFFO], DFF, D_, nullptr, Wffo_t, scr, r, lane);
        }
        for (int m0 = gw; m0 < M_; m0 += 2 * NGW) { f32x4 v[2][4];
#pragma unroll
            for (int rr = 0; rr < 2; ++rr) { const int m = m0 + rr * NGW; if (m < M_) { const f32x4* xr = (const f32x4*)(P.in[I_X] + (size_t)m * D_) + lane;
#pragma unroll
                for (int jx = 0; jx < 4; ++jx) v[rr][jx] = xr[64 * jx]; } }
#pragma unroll
            for (int rr = 0; rr < 2; ++rr) { const int m = m0 + rr * NGW; if (m < M_) { float s = 0.f;
#pragma unroll
                for (int jx = 0; jx < 4; ++jx) s += (v[rr][jx][0] * v[rr][jx][0] + v[rr][jx][1] * v[rr][jx][1]) + (v[rr][jx][2] * v[rr][jx][2] + v[rr][jx][3] * v[rr][jx][3]);
                s = wave_sum(s); if (lane == 0) ss0[m] = s;
                u32x2* o8 = (u32x2*)(XB + (size_t)m * D_) + lane;
#pragma unroll
                for (int jx = 0; jx < 4; ++jx) { u32x2 w; w.x = pkbf(v[rr][jx][0], v[rr][jx][1]); w.y = pkbf(v[rr][jx][2], v[rr][jx][3]); o8[64 * jx] = w; } } } }
        for (int i = blk * NTHR + tid; i < 2 * M_; i += G * NTHR) ss1[i] = 0.f;
        for (int f = blk * NTHR + tid; f < 16 * 4 * 4 * 2 * 64; f += G * NTHR) { const int ln = f & 63, ks = (f >> 6) & 1, n = (f >> 7) & 3, cgx = (f >> 9) & 3, hh = f >> 11;
            const float* src = ((n & 1) ? P.in[I_WX] : P.in[I_WA]) + (size_t)(((n >> 1) * 16 + hh) * 64) * 64; const int col = 16 * cgx + (ln & 15), k0 = 32 * ks + 8 * (ln >> 4);
            u32x4 w; w.x = pkbf(src[(k0 + 0) * 64 + col], src[(k0 + 1) * 64 + col]); w.y = pkbf(src[(k0 + 2) * 64 + col], src[(k0 + 3) * 64 + col]);
            w.z = pkbf(src[(k0 + 4) * 64 + col], src[(k0 + 5) * 64 + col]); w.w = pkbf(src[(k0 + 6) * 64 + col], src[(k0 + 7) * 64 + col]);
            *(u32x4*)(WG + (size_t)f * 8) = w; }
    }
    SEAM(0);
    if (IN(1)) {
        pg8::Gemm g{XB, Win_t, M_, INW, D_}; pg8::StaticOrder S; S.init(M_, INW, G, blk);
        pg8::EpiProj E{PROJ, VT, ss0, QSCALE};
        pg8::gemm_phase<pg8::EpiProj, pg8::StaticOrder, true, true>(lds, g, S, E);
    }
    SEAM(1);
    if (IN(2)) {
        attn_phase(lds, PROJ, VT, P.in[I_SINK], blk, G, tid);
        for (int rr = blk; rr < 256; rr += G) { const int b = rr >> 7, h = (rr >> 3) & 15, run = rr & 7;
            scan_run<false>(lds, PROJ, WG, P.in[I_CONVW], P.in[I_CONVB], P.in[I_LAM], P.in[I_BA], P.in[I_BX], P.in[I_BGATE], cagg, MERGED, b, h, 8 * run, tid); }
    }
    SEAM(2);
    if (IN(3)) {
        for (int rr = blk; rr < 256; rr += G) { const int b = rr >> 7, h = (rr >> 3) & 15, run = rr & 7;
            __syncthreads();
            scan_run<true>(lds, PROJ, WG, P.in[I_CONVW], P.in[I_CONVB], P.in[I_LAM], P.in[I_BA], P.in[I_BX], P.in[I_BGATE], cagg, MERGED, b, h, 8 * run, tid); }
    }
    SEAM(3);
    if (IN(4)) {
        pg8::Gemm g{MERGED, Wout_t, M_, D_, D_}; pg8::StaticOrder S; S.init(M_, D_, G, blk);
        pg8::EpiResid<0> E{P.in[I_X], nullptr, nullptr, X1B, ss1};
        pg8::gemm_phase<pg8::EpiResid<0>, pg8::StaticOrder, true, true>(lds, g, S, E);
    }
    SEAM(4);
    if (IN(5)) {
        pg8::Gemm g{X1B, Wffi_t, M_, INW, D_}; pg8::StaticOrder S; S.init(M_, INW, G, blk);
        pg8::EpiSwiGLU E{HB, ss1};
        pg8::gemm_phase<pg8::EpiSwiGLU, pg8::StaticOrder, true, true>(lds, g, S, E);
    }
    SEAM(5);
    if (IN(6)) {
        pg8::Gemm g{HB, Wffo_t, M_, D_, DFF}; pg8::StaticOrder S; S.init(M_, D_, G, blk);
        pg8::EpiResid<1> E{nullptr, X1B, P.out, nullptr, ss2};
        pg8::gemm_phase<pg8::EpiResid<1>, pg8::StaticOrder, true, true>(lds, g, S, E);
    }
    SEAM(6);
    if (IN(7)) {
        const int gw = blk * NWAVES + wave, NGW = G * NWAVES;
        f32x4 gf[4];
#pragma unroll
        for (int jx = 0; jx < 4; ++jx) gf[jx] = ((const f32x4*)P.in[I_GFIN])[lane + 64 * jx];
        for (int m = gw; m < M_; m += NGW) { f32x4* xr = (f32x4*)(P.out + (size_t)m * D_) + lane; const float rs = rsqrtf(ss2[m] * (1.0f / 1024.0f) + 1e-6f);
#pragma unroll
            for (int jx = 0; jx < 4; ++jx) { f32x4 v = xr[64 * jx]; xr[64 * jx] = v * rs * gf[jx]; } }
    }
#undef IN
#undef SEAM
}

extern "C" void kernel_launch(void* const* d_in, const int* in_sizes, int n_in, void* d_out, int out_size, void* d_ws, size_t ws_size, hipStream_t stream) {
    static int grid = 0;
    if (grid == 0) {
        if (n_in != 17 || out_size != M_ * D_ || ws_size < WS_END) { fprintf(stderr, "kernel_launch: unexpected problem (n_in %d, out %d, ws %zu)\n", n_in, out_size, ws_size); grid = -1; return; }
        int dev = 0, cus = 0, per_cu = 0;
        if (hipGetDevice(&dev) != hipSuccess || hipDeviceGetAttribute(&cus, hipDeviceAttributeMultiprocessorCount, dev) != hipSuccess) { grid = -1; return; }
        if (hipFuncSetAttribute((const void*)fwd_kernel, hipFuncAttributeMaxDynamicSharedMemorySize, LDS_BYTES) != hipSuccess) { fprintf(stderr, "kernel_launch: hipFuncSetAttribute failed\n"); grid = -1; return; }
        if (hipOccupancyMaxActiveBlocksPerMultiprocessor(&per_cu, (const void*)fwd_kernel, NTHR, LDS_BYTES) != hipSuccess || per_cu < 1) { fprintf(stderr, "kernel_launch: occupancy query says %d blocks/CU\n", per_cu); grid = -1; return; }
        grid = cus;
    }
    if (grid < 0) return;
    if (hipMemsetAsync((char*)d_ws + WS_BAR, 0, BAR_BYTES, stream) != hipSuccess) { fprintf(stderr, "kernel_launch: memset failed\n"); return; }
    Params p{};
    for (int i = 0; i < 17; ++i) p.in[i] = (const float*)d_in[i];
    p.out = (float*)d_out; p.ws = (unsigned char*)d_ws;
#if MK_LAUNCHES == 1
    p.ph_lo = 0; p.ph_hi = NPH; p.cg_seams = 0;
    void* args[] = {&p};
    hipError_t e = hipLaunchCooperativeKernel((const void*)fwd_kernel, dim3(grid), dim3(NTHR), args, LDS_BYTES, stream);
    if (e != hipSuccess) fprintf(stderr, "kernel_launch: cooperative launch failed: %s (grid %d)\n", hipGetErrorString(e), grid);
#else
    for (int ph = 0; ph < NPH; ++ph) { p.ph_lo = ph; p.ph_hi = ph + 1; hipLaunchKernelGGL(fwd_kernel, dim3(grid), dim3(NTHR), LDS_BYTES, stream, p); }
#endif
}
```
